# Optimizing an MI355X kernel written in HIP

```python
import math
import jax
import jax.numpy as jnp
from jax import lax
import numpy as np

D_MODEL = 1024
BATCH = 4
SEQ = 4096
DEPTH = 1
DEC_BATCH = 16
DEC_SEQ = 32
PAST_LEN = 2048

CHUNK = 64
N_META = 16
N_HEADS = 8
QK_NOPE = 128
QK_ROPE = 64
V_DIM = 128
QK_DIM = QK_NOPE + QK_ROPE
Q_LORA = 384
KV_LORA = 256
D_SSM = D_MODEL
SSM_GROUP = 16
N_GROUPS = D_SSM // SSM_GROUP
SSM_STATE = 64
D_FF = 4 * D_MODEL
Q_BLOCK = 128
ROPE_THETA = 10000.0
EPS = 1e-6
ATTN_SCALE = QK_DIM ** -0.5
NEG_INF = -1e30

O_KV = Q_LORA
O_KR = O_KV + KV_LORA
O_SSM = O_KR + QK_ROPE
O_GA = O_SSM + D_SSM
O_GB = O_GA + D_MODEL
IN_COLS = O_GB + D_MODEL

kernel_name = "mla_s5_gated_streaming_encoder_step"


def rmsnorm(x, g):
    xf = x.astype(jnp.float32)
    y = xf * lax.rsqrt(jnp.mean(xf * xf, axis=-1, keepdims=True) + EPS)
    return (y * g.astype(jnp.float32)).astype(x.dtype)


def rope(x, pos):
    half = QK_ROPE // 2
    inv = ROPE_THETA ** (-jnp.arange(half, dtype=jnp.float32) / half)
    ang = pos.astype(jnp.float32)[:, None] * inv[None, :]
    ang = ang.reshape((ang.shape[0],) + (1,) * (x.ndim - 3) + (half,))
    cos, sin = jnp.cos(ang), jnp.sin(ang)
    xf = x.astype(jnp.float32)
    x1, x2 = xf[..., :half], xf[..., half:]
    return jnp.concatenate([x1 * cos - x2 * sin, x2 * cos + x1 * sin], axis=-1).astype(x.dtype)


def attend(q, k, v, mask):
    s = jnp.einsum("bqhd,bkhd->bhqk", q.astype(jnp.float32), k.astype(jnp.float32)) * ATTN_SCALE
    if mask is not None:
        s = jnp.where(mask[None, None], s, NEG_INF)
    p = jax.nn.softmax(s, axis=-1)
    return jnp.einsum("bhqk,bkhv->bqhv", p, v.astype(jnp.float32)).astype(v.dtype)


def mla_expand(c_kv, k_rope, p):
    kv = jnp.einsum("bkc,chd->bkhd", c_kv, p["w_ukv"])
    k_nope = rmsnorm(kv[..., :QK_NOPE], p["k_nope_norm"])
    v = kv[..., QK_NOPE:]
    kr = jnp.broadcast_to(k_rope[:, :, None, :], k_nope.shape[:3] + (QK_ROPE,)).astype(k_nope.dtype)
    return jnp.concatenate([k_nope, kr], axis=-1), v


def block_causal_attention(q, k, v):
    bsz, L = q.shape[0], q.shape[1]
    n_real = L - N_META
    o_meta = attend(q[:, :N_META], k[:, :N_META], v[:, :N_META], None)
    key_chunk = jnp.concatenate([jnp.full((N_META,), -1, jnp.int32),
                                 jnp.arange(n_real, dtype=jnp.int32) // CHUNK])
    n_blk = n_real // Q_BLOCK
    q_blocks = q[:, N_META:].reshape(bsz, n_blk, Q_BLOCK, N_HEADS, QK_DIM).transpose(1, 0, 2, 3, 4)

    def one_block(args):
        qb, i = args
        q_chunk = (i * Q_BLOCK + jnp.arange(Q_BLOCK, dtype=jnp.int32)) // CHUNK
        mask = key_chunk[None, :] <= q_chunk[:, None]
        return attend(qb, k, v, mask)

    o = lax.map(one_block, (q_blocks, jnp.arange(n_blk, dtype=jnp.int32)))
    o = o.transpose(1, 0, 2, 3, 4).reshape(bsz, n_real, N_HEADS, V_DIM)
    return jnp.concatenate([o_meta, o], axis=1)


def complex_affine_combine(e1, e2):
    a1r, a1i, b1r, b1i = e1
    a2r, a2i, b2r, b2i = e2
    return (a2r * a1r - a2i * a1i,
            a2r * a1i + a2i * a1r,
            a2r * b1r - a2i * b1i + b2r,
            a2r * b1i + a2i * b1r + b2i)


def s5_scan(u, h0_re, h0_im, p):
    f32 = jnp.float32
    a_re = p["ssm_a_re"].astype(f32)
    a_im = p["ssm_a_im"].astype(f32)
    dt = jnp.exp(p["ssm_log_dt"].astype(f32))[:, None]
    mag = jnp.exp(a_re * dt)
    lam_re, lam_im = mag * jnp.cos(a_im * dt), mag * jnp.sin(a_im * dt)
    den = a_re * a_re + a_im * a_im
    f_re = ((lam_re - 1.0) * a_re + lam_im * a_im) / den
    f_im = (lam_im * a_re - (lam_re - 1.0) * a_im) / den
    bsz, L = u.shape[0], u.shape[1]
    ug = u.astype(f32).reshape(bsz, L, N_GROUPS, SSM_GROUP)
    bu_re = jnp.einsum("blgc,gnc->blgn", ug, p["ssm_b_re"].astype(f32))
    bu_im = jnp.einsum("blgc,gnc->blgn", ug, p["ssm_b_im"].astype(f32))
    x_re = f_re * bu_re - f_im * bu_im
    x_im = f_re * bu_im + f_im * bu_re
    ar = jnp.broadcast_to(lam_re, x_re.shape)
    ai = jnp.broadcast_to(lam_im, x_re.shape)
    ar, ai, sr, si = lax.associative_scan(complex_affine_combine, (ar, ai, x_re, x_im), axis=1)
    h0r = h0_re.astype(f32)[:, None]
    h0i = h0_im.astype(f32)[:, None]
    hr = sr + ar * h0r - ai * h0i
    hi = si + ar * h0i + ai * h0r
    y = (jnp.einsum("blgn,gcn->blgc", hr, p["ssm_c_re"].astype(f32))
         - jnp.einsum("blgn,gcn->blgc", hi, p["ssm_c_im"].astype(f32)))
    y = y.reshape(bsz, L, D_SSM) + p["ssm_d"].astype(f32) * u.astype(f32)
    return y, hr[:, -1], hi[:, -1]


def hybrid_layer(h, pos, prefix, h0_re, h0_im, p):
    xn = rmsnorm(h, p["norm_mix"])
    z = jnp.einsum("bld,dc->blc", xn, p["w_in"])
    q_lat, kv_lat, kr_raw = z[..., :O_KV], z[..., O_KV:O_KR], z[..., O_KR:O_SSM]
    u, g_a, g_b = z[..., O_SSM:O_GA], z[..., O_GA:O_GB], z[..., O_GB:]
    c_q = rmsnorm(q_lat, p["q_lora_norm"])
    q = jnp.einsum("blr,rhd->blhd", c_q, p["w_uq"])
    q = jnp.concatenate([rmsnorm(q[..., :QK_NOPE], p["q_nope_norm"]),
                         rope(rmsnorm(q[..., QK_NOPE:], p["q_rope_norm"]), pos)], axis=-1)
    c_kv = rmsnorm(kv_lat, p["kv_lora_norm"])
    k_rope = rope(rmsnorm(kr_raw, p["k_rope_norm"]), pos)
    if prefix is None:
        k, v = mla_expand(c_kv, k_rope, p)
        o_attn = block_causal_attention(q, k, v)
    else:
        pre_c, pre_kr = prefix
        k, v = mla_expand(jnp.concatenate([pre_c, c_kv], axis=1),
                          jnp.concatenate([pre_kr, k_rope], axis=1), p)
        o_attn = attend(q, k, v, None)
    o_a = jnp.einsum("blhv,hvd->bld", o_attn, p["w_o_attn"])
    y_ssm, hr, hi = s5_scan(u, h0_re, h0_im, p)
    s = jax.nn.gelu(y_ssm)
    o_b = (s @ p["w_glu_v"]) * jax.nn.sigmoid(s @ p["w_glu_g"])
    merged = jax.nn.sigmoid(g_a) * o_a + jax.nn.sigmoid(g_b) * o_b
    h = h + merged @ p["w_out"]
    a = jax.nn.relu(rmsnorm(h, p["norm_mlp"]) @ p["w_mlp_up"])
    h = h + (a * a) @ p["w_mlp_down"]
    return h, c_kv, k_rope, hr, hi


def setup_inputs(seed: int = 0) -> dict:
    key = jax.random.key(seed)
    ks = jax.random.split(key, 40)
    nrm = jax.random.normal
    f32 = jnp.float32

    def gain(k, shape):
        return 1.0 + 0.02 * nrm(k, shape, f32)

    n_idx = jnp.arange(SSM_STATE, dtype=f32)
    return {
        "x_prompt": nrm(ks[0], (BATCH, SEQ, D_MODEL), f32),
        "x_sample": nrm(ks[1], (DEC_BATCH, DEC_SEQ, D_MODEL), f32),
        "cache_latent": nrm(ks[2], (DEPTH, DEC_BATCH, PAST_LEN, KV_LORA), f32),
        "cache_krope": nrm(ks[3], (DEPTH, DEC_BATCH, PAST_LEN, QK_ROPE), f32),
        "cache_meta_latent": nrm(ks[4], (DEPTH, DEC_BATCH, N_META, KV_LORA), f32),
        "cache_meta_krope": nrm(ks[5], (DEPTH, DEC_BATCH, N_META, QK_ROPE), f32),
        "state_ssm_re": 0.5 * nrm(ks[6], (DEPTH, DEC_BATCH, N_GROUPS, SSM_STATE), f32),
        "state_ssm_im": 0.5 * nrm(ks[7], (DEPTH, DEC_BATCH, N_GROUPS, SSM_STATE), f32),
        "meta_tokens": nrm(ks[8], (N_META, D_MODEL), f32),
        "norm_mix": gain(ks[9], (DEPTH, D_MODEL)),
        "w_in": nrm(ks[10], (DEPTH, D_MODEL, IN_COLS), f32) * D_MODEL ** -0.5,
        "q_lora_norm": gain(ks[11], (DEPTH, Q_LORA)),
        "w_uq": nrm(ks[12], (DEPTH, Q_LORA, N_HEADS, QK_DIM), f32) * Q_LORA ** -0.5,
        "q_nope_norm": gain(ks[13], (DEPTH, QK_NOPE)),
        "q_rope_norm": gain(ks[14], (DEPTH, QK_ROPE)),
        "kv_lora_norm": gain(ks[15], (DEPTH, KV_LORA)),
        "k_rope_norm": gain(ks[16], (DEPTH, QK_ROPE)),
        "w_ukv": nrm(ks[17], (DEPTH, KV_LORA, N_HEADS, QK_NOPE + V_DIM), f32) * KV_LORA ** -0.5,
        "k_nope_norm": gain(ks[18], (DEPTH, QK_NOPE)),
        "w_o_attn": nrm(ks[19], (DEPTH, N_HEADS, V_DIM, D_MODEL), f32) * (N_HEADS * V_DIM) ** -0.5,
        "ssm_a_re": -0.5 + 0.01 * nrm(ks[20], (DEPTH, N_GROUPS, SSM_STATE), f32),
        "ssm_a_im": math.pi * n_idx + 0.01 * nrm(ks[21], (DEPTH, N_GROUPS, SSM_STATE), f32),
        "ssm_log_dt": jax.random.uniform(ks[22], (DEPTH, N_GROUPS), f32, math.log(1e-3), math.log(1e-1)),
        "ssm_b_re": nrm(ks[23], (DEPTH, N_GROUPS, SSM_STATE, SSM_GROUP), f32) * (2 * SSM_GROUP) ** -0.5,
        "ssm_b_im": nrm(ks[24], (DEPTH, N_GROUPS, SSM_STATE, SSM_GROUP), f32) * (2 * SSM_GROUP) ** -0.5,
        "ssm_c_re": nrm(ks[25], (DEPTH, N_GROUPS, SSM_GROUP, SSM_STATE), f32) * SSM_STATE ** -0.5,
        "ssm_c_im": nrm(ks[26], (DEPTH, N_GROUPS, SSM_GROUP, SSM_STATE), f32) * SSM_STATE ** -0.5,
        "ssm_d": nrm(ks[27], (DEPTH, D_SSM), f32),
        "w_glu_v": nrm(ks[28], (DEPTH, D_SSM, D_MODEL), f32) * D_SSM ** -0.5,
        "w_glu_g": nrm(ks[29], (DEPTH, D_SSM, D_MODEL), f32) * D_SSM ** -0.5,
        "w_out": nrm(ks[30], (DEPTH, D_MODEL, D_MODEL), f32) * D_MODEL ** -0.5,
        "norm_mlp": gain(ks[31], (DEPTH, D_MODEL)),
        "w_mlp_up": nrm(ks[32], (DEPTH, D_MODEL, D_FF), f32) * D_MODEL ** -0.5,
        "w_mlp_down": nrm(ks[33], (DEPTH, D_FF, D_MODEL), f32) * D_FF ** -0.5,
    }


def reference(x_prompt, x_sample, cache_latent, cache_krope, cache_meta_latent, cache_meta_krope,
              state_ssm_re, state_ssm_im, meta_tokens, norm_mix, w_in, q_lora_norm, w_uq,
              q_nope_norm, q_rope_norm, kv_lora_norm, k_rope_norm, w_ukv, k_nope_norm, w_o_attn,
              ssm_a_re, ssm_a_im, ssm_log_dt, ssm_b_re, ssm_b_im, ssm_c_re, ssm_c_im, ssm_d,
              w_glu_v, w_glu_g, w_out, norm_mlp, w_mlp_up, w_mlp_down):
    bsz_p, seq_p = x_prompt.shape[0], x_prompt.shape[1]
    seq_s = x_sample.shape[1]
    meta = jnp.broadcast_to(meta_tokens[None].astype(x_prompt.dtype), (bsz_p, N_META, D_MODEL))
    hp = jnp.concatenate([meta, x_prompt], axis=1)
    pos_p = jnp.arange(N_META + seq_p, dtype=jnp.int32) - N_META
    hs = x_sample
    pos_s = PAST_LEN + jnp.arange(seq_s, dtype=jnp.int32)
    h0_zero = jnp.zeros((bsz_p, N_GROUPS, SSM_STATE), jnp.float32)

    lat_p, kr_p, mlat_p, mkr_p, sre_p, sim_p = [], [], [], [], [], []
    lat_s, kr_s, sre_s, sim_s = [], [], [], []
    for l in range(DEPTH):
        p = dict(norm_mix=norm_mix[l], w_in=w_in[l], q_lora_norm=q_lora_norm[l], w_uq=w_uq[l],
                 q_nope_norm=q_nope_norm[l], q_rope_norm=q_rope_norm[l], kv_lora_norm=kv_lora_norm[l],
                 k_rope_norm=k_rope_norm[l], w_ukv=w_ukv[l], k_nope_norm=k_nope_norm[l],
                 w_o_attn=w_o_attn[l], ssm_a_re=ssm_a_re[l], ssm_a_im=ssm_a_im[l],
                 ssm_log_dt=ssm_log_dt[l], ssm_b_re=ssm_b_re[l], ssm_b_im=ssm_b_im[l],
                 ssm_c_re=ssm_c_re[l], ssm_c_im=ssm_c_im[l], ssm_d=ssm_d[l], w_glu_v=w_glu_v[l],
                 w_glu_g=w_glu_g[l], w_out=w_out[l], norm_mlp=norm_mlp[l], w_mlp_up=w_mlp_up[l],
                 w_mlp_down=w_mlp_down[l])
        hp, c_kv, k_rope, hr, hi = hybrid_layer(hp, pos_p, None, h0_zero, h0_zero, p)
        mlat_p.append(c_kv[:, :N_META])
        mkr_p.append(k_rope[:, :N_META])
        lat_p.append(c_kv[:, N_META:])
        kr_p.append(k_rope[:, N_META:])
        sre_p.append(hr)
        sim_p.append(hi)
        prefix = (jnp.concatenate([cache_meta_latent[l], cache_latent[l]], axis=1),
                  jnp.concatenate([cache_meta_krope[l], cache_krope[l]], axis=1))
        hs, c_kv, k_rope, hr, hi = hybrid_layer(hs, pos_s, prefix, state_ssm_re[l], state_ssm_im[l], p)
        lat_s.append(c_kv)
        kr_s.append(k_rope)
        sre_s.append(hr)
        sim_s.append(hi)

    y_prompt = hp[:, N_META:]
    y_sample = hs
    return (y_prompt, y_sample,
            jnp.stack(lat_p), jnp.stack(kr_p), jnp.stack(mlat_p), jnp.stack(mkr_p),
            jnp.stack(sre_p), jnp.stack(sim_p),
            jnp.stack(lat_s), jnp.stack(kr_s), jnp.stack(sre_s), jnp.stack(sim_s))
```

```cpp
#include <hip/hip_runtime.h>
#include <cstdio>
#include <cstdint>

typedef unsigned short bf16_t;
typedef short bf16x8 __attribute__((ext_vector_type(8)));
typedef float f32x4 __attribute__((ext_vector_type(4)));

constexpr int D = 1024, NB = 4, SEQ = 4096, DB = 16, DS = 32, PAST = 2048;
constexpr int NMETA = 16, NH = 8, NOPE = 128, ROPE = 64, VD = 128, QKD = 192, QL = 384, KVL = 256;
constexpr int NG = 64, GS = 16, NS = 64, DFF = 4096;
constexpr int INC = 3776, O_KV = 384, O_KR = 640, O_SSM = 704, O_GA = 1728, O_GB = 2752, INCP = 3840;
constexpr float EPS = 1e-6f;
constexpr float ATTN_SCALE = 0.07216878364870322f;
constexpr int LP = NMETA + SEQ;

constexpr int TM = NB * SEQ, TS0 = TM, TS = DB * DS, TMETA0 = TS0 + TS, T = TMETA0 + NB * NMETA, TOUT = TMETA0;
constexpr int KV_SC0 = TM, KV_T0 = KV_SC0 + DB * PAST, KV_PM0 = KV_T0, KV_ST0 = KV_T0 + NB * 64, KVR = KV_ST0 + DB * 64, KVT = KVR - KV_T0;

constexpr size_t OO_Y = 0, OO_YS = OO_Y + (size_t)NB * SEQ * D, OO_LATP = OO_YS + (size_t)DB * DS * D, OO_KRP = OO_LATP + (size_t)NB * SEQ * KVL,
                 OO_MLAT = OO_KRP + (size_t)NB * SEQ * ROPE, OO_MKR = OO_MLAT + (size_t)NB * NMETA * KVL, OO_SREP = OO_MKR + (size_t)NB * NMETA * ROPE,
                 OO_SIMP = OO_SREP + (size_t)NB * NG * NS, OO_LATS = OO_SIMP + (size_t)NB * NG * NS, OO_KRS = OO_LATS + (size_t)DB * DS * KVL,
                 OO_SRES = OO_KRS + (size_t)DB * DS * ROPE, OO_SIMS = OO_SRES + (size_t)DB * NG * NS, OO_END = OO_SIMS + (size_t)DB * NG * NS;
static_assert(OO_END == 22892544, "output size");

constexpr size_t MiB = 1u << 20;
constexpr size_t TB = (size_t)T * D * 2;
constexpr size_t WS_WIN = 2 * MiB, WS_WUQ = WS_WIN + (size_t)INCP * D * 2, WS_WUKV = WS_WUQ + (size_t)NH * QKD * QL * 2, WS_WO = WS_WUKV + (size_t)2048 * KVL * 2,
                 WS_WGLU = WS_WO + (size_t)D * D * 2, WS_WOUT = WS_WGLU + (size_t)2 * D * D * 2, WS_WUP = WS_WOUT + (size_t)D * D * 2, WS_WDN = WS_WUP + (size_t)DFF * D * 2,
                 WS_WEND = WS_WDN + (size_t)DFF * D * 2;
static_assert(WS_WEND <= 36 * MiB, "weights");
constexpr size_t WS_ROPE = 36 * MiB;
constexpr size_t WS_KR = 37 * MiB + 512 * 1024;
static_assert(WS_ROPE + (size_t)LP * 32 * 2 * 4 <= WS_KR && WS_KR + (size_t)KVR * ROPE * 2 <= 44 * MiB, "small region");
constexpr size_t WS_GA = 44 * MiB, WS_GB = 78 * MiB, WS_E = 112 * MiB;
static_assert(WS_GA + TB <= WS_GB && WS_GB + TB <= WS_E && WS_E + TB <= 146 * MiB, "T buffers");
constexpr size_t WS_F = 146 * MiB;
constexpr size_t WS_ZQ = WS_F, WS_U = WS_ZQ + (size_t)T * O_SSM * 2, WS_CQ = WS_U + TB, WS_CALL = 231 * MiB;
static_assert(WS_CQ + (size_t)T * QL * 2 <= 215 * MiB && WS_CALL + (size_t)KVR * KVL * 2 <= 256 * MiB, "F region P1-P2");
constexpr size_t WS_QM = WS_F;
static_assert(WS_QM + (size_t)TM * NH * QKD * 2 <= WS_CQ, "Qmain vs CQ");
constexpr size_t WS_KT = 215 * MiB, WS_VT = WS_KT + (size_t)KVT * D * 2, WS_QT = WS_VT + (size_t)KVT * D * 2;
static_assert(WS_QT + (size_t)(T - TM) * NH * QKD * 2 <= WS_CALL, "tail region");
constexpr size_t WS_VS = WS_F;
static_assert(WS_VS + (size_t)DB * PAST * D * 2 <= WS_KT, "Vs");
constexpr size_t WS_A1T = WS_E, WS_A1M = 128 * MiB;
static_assert(WS_A1T + (size_t)TS * DFF * 2 <= WS_A1M && WS_A1M + (size_t)TM * DFF * 2 <= 256 * MiB, "A1");

__device__ __forceinline__ float bf2f(bf16_t v) { return __uint_as_float((unsigned)v << 16); }
__device__ __forceinline__ bf16_t f2bf(float f) { unsigned u = __float_as_uint(f); return (bf16_t)((u + 0x7fffu + ((u >> 16) & 1u)) >> 16); }
__device__ __forceinline__ float wave_sum(float v) {
#pragma unroll
    for (int o = 1; o < 64; o <<= 1) v += __shfl_xor(v, o);
    return v;
}
__device__ __forceinline__ float wave_max(float v) {
#pragma unroll
    for (int o = 1; o < 64; o <<= 1) v = fmaxf(v, __shfl_xor(v, o));
    return v;
}
__device__ __forceinline__ float sigmoidf_(float x) { return 1.f / (1.f + __expf(-x)); }
__device__ __forceinline__ float gelu_tanh(float x) { const float u = 0.7978845608028654f * (x + 0.044715f * x * x * x); return 0.5f * x * (1.f + tanhf(u)); }
__device__ __forceinline__ int row_pos(int r) { return r < TM ? (r & (SEQ - 1)) : (r < TMETA0 ? PAST + ((r - TS0) & (DS - 1)) : ((r - TMETA0) & (NMETA - 1)) - NMETA); }
__device__ __forceinline__ int row_kvr(int r) {
    if (r < TM) return r;
    if (r < TMETA0) { const int s = r - TS0; return KV_ST0 + (s >> 5) * 64 + (s & 31); }
    const int s = r - TMETA0; return KV_PM0 + (s >> 4) * 64 + (s & 15);
}

struct Params {
    const float* in[34];
    float* out;
    unsigned char* ws;
};

__global__ void k_transpose(const float* __restrict__ src, const float* __restrict__ src2, bf16_t* __restrict__ dst, int K, int Nsrc, int Ndst, int mode) {
    const size_t total = (size_t)Ndst * K;
    for (size_t i = (size_t)blockIdx.x * blockDim.x + threadIdx.x; i < total; i += (size_t)gridDim.x * blockDim.x) {
        const int k = (int)(i / Ndst), n = (int)(i % Ndst);
        float v = 0.f;
        if (mode == 0) { if (n < Nsrc) v = src[(size_t)k * Nsrc + n]; }
        else { const int blk = n >> 8, w = n & 255; v = (w < 128) ? src[(size_t)k * Nsrc + blk * 128 + w] : src2[(size_t)k * Nsrc + blk * 128 + (w - 128)]; }
        dst[(size_t)n * K + k] = f2bf(v);
    }
}
__global__ void k_rope_table(float* __restrict__ tab) {
    const int i = blockIdx.x * blockDim.x + threadIdx.x;
    if (i >= LP * 32) return;
    const int p = i >> 5, f = i & 31;
    const double inv = exp2(-(double)f * (13.287712379549449 / 32.0));
    const double ang = (double)(p - NMETA) * inv;
    const double rev = ang * 0.15915494309189535;
    const double fr = rev - rint(rev);
    const float a = (float)(fr * 6.283185307179586);
    tab[2 * i] = cosf(a); tab[2 * i + 1] = sinf(a);
}
__global__ void k_cache_prep(Params P) {
    bf16_t* CALL = (bf16_t*)(P.ws + WS_CALL); bf16_t* KR = (bf16_t*)(P.ws + WS_KR);
    const float* clat = P.in[2]; const float* ckr = P.in[3]; const float* mlat = P.in[4]; const float* mkr = P.in[5];
    const size_t gsz = (size_t)gridDim.x * blockDim.x, g0 = (size_t)blockIdx.x * blockDim.x + threadIdx.x;
    for (size_t i = g0; i < (size_t)DB * PAST * KVL; i += gsz) CALL[(size_t)KV_SC0 * KVL + i] = f2bf(clat[i]);
    for (size_t i = g0; i < (size_t)DB * PAST * ROPE; i += gsz) KR[(size_t)KV_SC0 * ROPE + i] = f2bf(ckr[i]);
    for (size_t i = g0; i < (size_t)KVT * KVL; i += gsz) {
        const int tr = (int)(i / KVL), c = (int)(i % KVL), slot = tr >> 6, j = tr & 63;
        if (slot < NB) { if (j >= NMETA) CALL[(size_t)(KV_T0 + tr) * KVL + c] = 0; }
        else { const int b = slot - NB; if (j >= 32 && j < 48) CALL[(size_t)(KV_T0 + tr) * KVL + c] = f2bf(mlat[((size_t)b * NMETA + (j - 32)) * KVL + c]); else if (j >= 48) CALL[(size_t)(KV_T0 + tr) * KVL + c] = 0; }
    }
    for (size_t i = g0; i < (size_t)KVT * ROPE; i += gsz) {
        const int tr = (int)(i / ROPE), c = (int)(i % ROPE), slot = tr >> 6, j = tr & 63;
        if (slot < NB) { if (j >= NMETA) KR[(size_t)(KV_T0 + tr) * ROPE + c] = 0; }
        else { const int b = slot - NB; if (j >= 32 && j < 48) KR[(size_t)(KV_T0 + tr) * ROPE + c] = f2bf(mkr[((size_t)b * NMETA + (j - 32)) * ROPE + c]); else if (j >= 48) KR[(size_t)(KV_T0 + tr) * ROPE + c] = 0; }
    }
}
__device__ __forceinline__ const float* x_row(const Params& P, int r) {
    if (r < TM) return P.in[0] + (size_t)r * D;
    if (r < TMETA0) return P.in[1] + (size_t)(r - TS0) * D;
    return P.in[8] + (size_t)((r - TMETA0) & (NMETA - 1)) * D;
}
__global__ void k_xn(Params P) {
    const int r = blockIdx.x * 4 + (threadIdx.x >> 6), lane = threadIdx.x & 63;
    if (r >= T) return;
    const float* x = x_row(P, r); const float* g = P.in[9];
    bf16_t* XN = (bf16_t*)(P.ws + WS_E);
    f32x4 v[4]; float ss = 0.f;
#pragma unroll
    for (int j = 0; j < 4; ++j) { v[j] = *(const f32x4*)(x + j * 256 + lane * 4); ss += v[j].x * v[j].x + v[j].y * v[j].y + v[j].z * v[j].z + v[j].w * v[j].w; }
    const float rs = rsqrtf(wave_sum(ss) * (1.f / D) + EPS);
#pragma unroll
    for (int j = 0; j < 4; ++j) { const f32x4 gg = *(const f32x4*)(g + j * 256 + lane * 4); bf16_t* o = XN + (size_t)r * D + j * 256 + lane * 4;
        o[0] = f2bf(v[j].x * rs * gg.x); o[1] = f2bf(v[j].y * rs * gg.y); o[2] = f2bf(v[j].z * rs * gg.z); o[3] = f2bf(v[j].w * rs * gg.w); }
}
__global__ void k_xn2(Params P) {
    const int r = blockIdx.x * 4 + (threadIdx.x >> 6), lane = threadIdx.x & 63;
    if (r >= TOUT) return;
    const float* x = P.out + (r < TM ? OO_Y + (size_t)r * D : OO_YS + (size_t)(r - TS0) * D); const float* g = P.in[31];
    bf16_t* XN = (bf16_t*)(P.ws + WS_GA);
    f32x4 v[4]; float ss = 0.f;
#pragma unroll
    for (int j = 0; j < 4; ++j) { v[j] = *(const f32x4*)(x + j * 256 + lane * 4); ss += v[j].x * v[j].x + v[j].y * v[j].y + v[j].z * v[j].z + v[j].w * v[j].w; }
    const float rs = rsqrtf(wave_sum(ss) * (1.f / D) + EPS);
#pragma unroll
    for (int j = 0; j < 4; ++j) { const f32x4 gg = *(const f32x4*)(g + j * 256 + lane * 4); bf16_t* o = XN + (size_t)r * D + j * 256 + lane * 4;
        o[0] = f2bf(v[j].x * rs * gg.x); o[1] = f2bf(v[j].y * rs * gg.y); o[2] = f2bf(v[j].z * rs * gg.z); o[3] = f2bf(v[j].w * rs * gg.w); }
}

template <class Epi>
__global__ void __launch_bounds__(256) k_gemm_simple(const bf16_t* __restrict__ A, int lda, const bf16_t* __restrict__ Bt, int ldb, int M, int N, int K, Epi E) {
    const int j = blockIdx.x * 16 + (threadIdx.x & 15), m = blockIdx.y * 16 + (threadIdx.x >> 4);
    if (m >= M || j >= N) return;
    const bf16_t* a = A + (size_t)m * lda; const bf16_t* b = Bt + (size_t)E.brow(j) * ldb;
    float acc = 0.f, acc2 = 0.f;
    if (Epi::DUAL) {
        const bf16_t* b2 = Bt + (size_t)E.brow2(j) * ldb;
        for (int k = 0; k < K; k += 8) { const bf16x8 av = *(const bf16x8*)(a + k), bv = *(const bf16x8*)(b + k), cv = *(const bf16x8*)(b2 + k);
#pragma unroll
            for (int i = 0; i < 8; ++i) { const float af = bf2f((bf16_t)av[i]); acc += af * bf2f((bf16_t)bv[i]); acc2 += af * bf2f((bf16_t)cv[i]); } }
    } else {
        for (int k = 0; k < K; k += 8) { const bf16x8 av = *(const bf16x8*)(a + k), bv = *(const bf16x8*)(b + k);
#pragma unroll
            for (int i = 0; i < 8; ++i) acc += bf2f((bf16_t)av[i]) * bf2f((bf16_t)bv[i]); }
    }
    E(m, j, acc, acc2);
}
struct EpiG1 {
    static constexpr bool DUAL = false;
    bf16_t *zq, *U, *GA, *GB;
    __device__ int brow(int j) const { return j; } __device__ int brow2(int j) const { return j; }
    __device__ void operator()(int r, int n, float acc, float) const {
        if (n < O_SSM) zq[(size_t)r * O_SSM + n] = f2bf(acc);
        else if (n < O_GA) { const int ch = n - O_SSM, g = ch >> 4, c = ch & 15; size_t idx;
            if (r < TM) { const int b = r >> 12, t = r & (SEQ - 1); idx = ((size_t)(b * NG + g) * LP + NMETA + t) * GS + c; }
            else if (r < TMETA0) { const int s = r - TS0, b = s >> 5, t = s & 31; idx = (size_t)NB * NG * LP * GS + ((size_t)(b * NG + g) * DS + t) * GS + c; }
            else { const int s = r - TMETA0, b = s >> 4, mm = s & 15; idx = ((size_t)(b * NG + g) * LP + mm) * GS + c; }
            U[idx] = f2bf(acc); }
        else if (n < O_GB) GA[(size_t)r * D + (n - O_GA)] = f2bf(sigmoidf_(acc));
        else if (n < INC) GB[(size_t)r * D + (n - O_GB)] = f2bf(sigmoidf_(acc));
    }
};
struct EpiQ {
    static constexpr bool DUAL = false;
    bf16_t *Qm, *Qt;
    __device__ int brow(int j) const { return j; } __device__ int brow2(int j) const { return j; }
    __device__ void operator()(int r, int n, float acc, float) const { if (r < TM) Qm[(size_t)r * (NH * QKD) + n] = f2bf(acc); else Qt[(size_t)(r - TM) * (NH * QKD) + n] = f2bf(acc); }
};
struct EpiKV {
    static constexpr bool DUAL = false;
    bf16_t *Kd, *Vd;
    __device__ int brow(int j) const { return j; } __device__ int brow2(int j) const { return j; }
    __device__ void operator()(int r, int n, float acc, float) const { const int h = n >> 8, d = n & 255; if (d < NOPE) Kd[(size_t)r * D + h * NOPE + d] = f2bf(acc); else Vd[(size_t)r * D + h * VD + (d - NOPE)] = f2bf(acc); }
};
struct EpiGlu {
    static constexpr bool DUAL = true;
    bf16_t* GB;
    __device__ int brow(int j) const { return (j >> 7) * 256 + (j & 127); } __device__ int brow2(int j) const { return (j >> 7) * 256 + 128 + (j & 127); }
    __device__ void operator()(int r, int j, float v, float g) const { bf16_t* p = GB + (size_t)r * D + j; *p = f2bf(bf2f(*p) * v * sigmoidf_(g)); }
};
struct EpiMerge {
    static constexpr bool DUAL = false;
    bf16_t* GA; const bf16_t* OB;
    __device__ int brow(int j) const { return j; } __device__ int brow2(int j) const { return j; }
    __device__ void operator()(int r, int j, float acc, float) const { bf16_t* p = GA + (size_t)r * D + j; *p = f2bf(bf2f(*p) * acc + bf2f(OB[(size_t)r * D + j])); }
};
struct EpiH1 {
    static constexpr bool DUAL = false;
    Params P;
    __device__ int brow(int j) const { return j; } __device__ int brow2(int j) const { return j; }
    __device__ void operator()(int r, int j, float acc, float) const {
        if (r < TM) P.out[OO_Y + (size_t)r * D + j] = P.in[0][(size_t)r * D + j] + acc; else P.out[OO_YS + (size_t)(r - TS0) * D + j] = P.in[1][(size_t)(r - TS0) * D + j] + acc; }
};
struct EpiUp {
    static constexpr bool DUAL = false;
    bf16_t *A1m, *A1t;
    __device__ int brow(int j) const { return j; } __device__ int brow2(int j) const { return j; }
    __device__ void operator()(int r, int j, float acc, float) const { const float a = fmaxf(acc, 0.f); const bf16_t v = f2bf(a * a); if (r < TM) A1m[(size_t)r * DFF + j] = v; else A1t[(size_t)(r - TM) * DFF + j] = v; }
};
struct EpiDown {
    static constexpr bool DUAL = false;
    float* O;
    __device__ int brow(int j) const { return j; } __device__ int brow2(int j) const { return j; }
    __device__ void operator()(int r, int j, float acc, float) const { O[(size_t)r * D + j] += acc; }
};

__global__ void k_norm1(Params P) {
    const int r = blockIdx.x * 4 + (threadIdx.x >> 6), lane = threadIdx.x & 63;
    if (r >= T) return;
    const bf16_t* z = (const bf16_t*)(P.ws + WS_ZQ) + (size_t)r * O_SSM;
    bf16_t* CQ = (bf16_t*)(P.ws + WS_CQ) + (size_t)r * QL;
    const int kvr = row_kvr(r);
    bf16_t* CA = (bf16_t*)(P.ws + WS_CALL) + (size_t)kvr * KVL; bf16_t* KR = (bf16_t*)(P.ws + WS_KR) + (size_t)kvr * ROPE;
    float *olat, *okr;
    if (r < TM) { olat = P.out + OO_LATP + (size_t)r * KVL; okr = P.out + OO_KRP + (size_t)r * ROPE; }
    else if (r < TMETA0) { olat = P.out + OO_LATS + (size_t)(r - TS0) * KVL; okr = P.out + OO_KRS + (size_t)(r - TS0) * ROPE; }
    else { olat = P.out + OO_MLAT + (size_t)(r - TMETA0) * KVL; okr = P.out + OO_MKR + (size_t)(r - TMETA0) * ROPE; }
    float q[6], kv[4], kr; float sq = 0.f, sk = 0.f;
#pragma unroll
    for (int i = 0; i < 6; ++i) { q[i] = bf2f(z[lane + 64 * i]); sq += q[i] * q[i]; }
#pragma unroll
    for (int i = 0; i < 4; ++i) { kv[i] = bf2f(z[O_KV + lane + 64 * i]); sk += kv[i] * kv[i]; }
    kr = bf2f(z[O_KR + lane]);
    const float rq = rsqrtf(wave_sum(sq) * (1.f / QL) + EPS), rk = rsqrtf(wave_sum(sk) * (1.f / KVL) + EPS), rr = rsqrtf(wave_sum(kr * kr) * (1.f / ROPE) + EPS);
#pragma unroll
    for (int i = 0; i < 6; ++i) CQ[lane + 64 * i] = f2bf(q[i] * rq * P.in[11][lane + 64 * i]);
#pragma unroll
    for (int i = 0; i < 4; ++i) { const float v = kv[i] * rk * P.in[15][lane + 64 * i]; olat[lane + 64 * i] = v; CA[lane + 64 * i] = f2bf(v); }
    const float y = kr * rr * P.in[16][lane], yo = __shfl_xor(y, 32);
    const float* tab = (const float*)(P.ws + WS_ROPE) + ((size_t)(row_pos(r) + NMETA) * 32 + (lane & 31)) * 2;
    const float c = tab[0], s = tab[1];
    const float o = lane < 32 ? y * c - yo * s : y * c + yo * s;
    okr[lane] = o; KR[lane] = f2bf(o);
}
__global__ void k_qnorm(Params P) {
    const int w = blockIdx.x * 4 + (threadIdx.x >> 6), lane = threadIdx.x & 63;
    if (w >= T * NH) return;
    const int r = w >> 3, h = w & 7;
    bf16_t* q = (r < TM ? (bf16_t*)(P.ws + WS_QM) + (size_t)r * (NH * QKD) : (bf16_t*)(P.ws + WS_QT) + (size_t)(r - TM) * (NH * QKD)) + h * QKD;
    const float a0 = bf2f(q[lane]), a1 = bf2f(q[lane + 64]), b = bf2f(q[NOPE + lane]);
    const float rn = rsqrtf(wave_sum(a0 * a0 + a1 * a1) * (1.f / NOPE) + EPS), rr = rsqrtf(wave_sum(b * b) * (1.f / ROPE) + EPS);
    q[lane] = f2bf(a0 * rn * P.in[13][lane]); q[lane + 64] = f2bf(a1 * rn * P.in[13][lane + 64]);
    const float y = b * rr * P.in[14][lane], yo = __shfl_xor(y, 32);
    const float* tab = (const float*)(P.ws + WS_ROPE) + ((size_t)(row_pos(r) + NMETA) * 32 + (lane & 31)) * 2;
    const float c = tab[0], s = tab[1];
    q[NOPE + lane] = f2bf(lane < 32 ? y * c - yo * s : y * c + yo * s);
}
__global__ void k_knorm(bf16_t* __restrict__ Kd, int rows, const float* __restrict__ g) {
    const int w = blockIdx.x * 4 + (threadIdx.x >> 6), lane = threadIdx.x & 63;
    if (w >= rows * NH) return;
    bf16_t* k = Kd + (size_t)(w >> 3) * D + (w & 7) * NOPE;
    const float a0 = bf2f(k[lane]), a1 = bf2f(k[lane + 64]);
    const float rn = rsqrtf(wave_sum(a0 * a0 + a1 * a1) * (1.f / NOPE) + EPS);
    k[lane] = f2bf(a0 * rn * g[lane]); k[lane + 64] = f2bf(a1 * rn * g[lane + 64]);
}

__global__ void __launch_bounds__(64) k_ssm_direct(Params P) {
    const int u = blockIdx.x, n = threadIdx.x;
    const bool prm = u < NB * NG;
    const int su = prm ? u : u - NB * NG, b = su >> 6, g = su & 63, L = prm ? LP : DS;
    const bf16_t* U = (const bf16_t*)(P.ws + WS_U) + (prm ? (size_t)u * LP * GS : (size_t)NB * NG * LP * GS + (size_t)su * DS * GS);
    bf16_t* SA = (bf16_t*)(P.ws + WS_E);
    const float are = P.in[20][g * NS + n], aim = P.in[21][g * NS + n], dt = expf(P.in[22][g]);
    const float mag = expf(are * dt), lre = mag * cosf(aim * dt), lim = mag * sinf(aim * dt), den = are * are + aim * aim;
    const float fre = ((lre - 1.f) * are + lim * aim) / den, fim = (lim * are - (lre - 1.f) * aim) / den;
    float bre[GS], bim[GS], cre[GS], cim[GS];
#pragma unroll
    for (int c = 0; c < GS; ++c) { bre[c] = P.in[23][(size_t)(g * NS + n) * GS + c]; bim[c] = P.in[24][(size_t)(g * NS + n) * GS + c];
        cre[c] = P.in[25][(size_t)(g * GS + c) * NS + n]; cim[c] = P.in[26][(size_t)(g * GS + c) * NS + n]; }
    const float dd = n < GS ? P.in[27][g * GS + n] : 0.f;
    float hre = prm ? 0.f : P.in[6][(size_t)su * NS + n], him = prm ? 0.f : P.in[7][(size_t)su * NS + n];
    for (int l = 0; l < L; ++l) {
        const bf16x8 u0 = *(const bf16x8*)(U + (size_t)l * GS), u1 = *(const bf16x8*)(U + (size_t)l * GS + 8);
        float uu[GS];
#pragma unroll
        for (int c = 0; c < 8; ++c) { uu[c] = bf2f((bf16_t)u0[c]); uu[8 + c] = bf2f((bf16_t)u1[c]); }
        float pr = 0.f, pi = 0.f;
#pragma unroll
        for (int c = 0; c < GS; ++c) { pr += uu[c] * bre[c]; pi += uu[c] * bim[c]; }
        const float xr = fre * pr - fim * pi, xi = fre * pi + fim * pr;
        const float nr = lre * hre - lim * him + xr, ni = lre * him + lim * hre + xi;
        hre = nr; him = ni;
        float mine = 0.f, myu = 0.f;
#pragma unroll
        for (int c = 0; c < GS; ++c) { const float s = wave_sum(hre * cre[c] - him * cim[c]); if (n == c) { mine = s; myu = uu[c]; } }
        if (n < GS) {
            const int row = prm ? (l < NMETA ? TMETA0 + b * NMETA + l : b * SEQ + (l - NMETA)) : TS0 + b * DS + l;
            SA[(size_t)row * D + g * GS + n] = f2bf(gelu_tanh(mine + dd * myu));
        }
    }
    float* ore = P.out + (prm ? OO_SREP : OO_SRES) + (size_t)su * NS; float* oim = P.out + (prm ? OO_SIMP : OO_SIMS) + (size_t)su * NS;
    ore[n] = hre; oim[n] = him;
}

struct KvPtrs { const bf16_t *Kp, *Vp, *Ks, *Vs, *Kt, *Vt, *KR; };
__device__ __forceinline__ const bf16_t* kv_row(const bf16_t* p, const bf16_t* s, const bf16_t* t, int kvr) {
    return kvr < KV_SC0 ? p + (size_t)kvr * D : (kvr < KV_T0 ? s + (size_t)(kvr - KV_SC0) * D : t + (size_t)(kvr - KV_T0) * D);
}
__global__ void __launch_bounds__(128) k_attn_simple(Params P, KvPtrs kp, int r0, int r1) {
    __shared__ float Ssc[2][LP];
    __shared__ float Qs[2][QKD];
    const int wv = threadIdx.x >> 6, lane = threadIdx.x & 63;
    const int w = blockIdx.x * 2 + wv;
    const int r = r0 + (w >> 3), h = w & 7;
    if (r >= r1) return;
    const bf16_t* q = (r < TM ? (const bf16_t*)(P.ws + WS_QM) + (size_t)r * (NH * QKD) : (const bf16_t*)(P.ws + WS_QT) + (size_t)(r - TM) * (NH * QKD)) + h * QKD;
    float* S = Ssc[wv]; float* Q = Qs[wv];
    Q[lane] = bf2f(q[lane]); Q[lane + 64] = bf2f(q[lane + 64]); Q[lane + 128] = bf2f(q[lane + 128]);
    int base1, n1, base2, n2;
    if (r < TM) { const int b = r >> 12, t = r & (SEQ - 1); base1 = KV_PM0 + b * 64; n1 = NMETA; base2 = b * SEQ; n2 = 64 * ((t >> 6) + 1); }
    else if (r < TMETA0) { const int b = (r - TS0) >> 5; base1 = KV_SC0 + b * PAST; n1 = PAST; base2 = KV_ST0 + b * 64; n2 = 48; }
    else { const int b = (r - TMETA0) >> 4; base1 = KV_PM0 + b * 64; n1 = NMETA; base2 = 0; n2 = 0; }
    const int nt = n1 + n2;
    __builtin_amdgcn_s_waitcnt(0);
    float mx = -1e30f;
    for (int i = lane; i < nt; i += 64) {
        const int kvr = i < n1 ? base1 + i : base2 + (i - n1);
        const bf16_t* k = kv_row(kp.Kp, kp.Ks, kp.Kt, kvr) + h * NOPE; const bf16_t* kr = kp.KR + (size_t)kvr * ROPE;
        float s = 0.f;
        for (int d = 0; d < NOPE; d += 8) { const bf16x8 kvv = *(const bf16x8*)(k + d);
#pragma unroll
            for (int e = 0; e < 8; ++e) s += Q[d + e] * bf2f((bf16_t)kvv[e]); }
        for (int d = 0; d < ROPE; d += 8) { const bf16x8 kvv = *(const bf16x8*)(kr + d);
#pragma unroll
            for (int e = 0; e < 8; ++e) s += Q[NOPE + d + e] * bf2f((bf16_t)kvv[e]); }
        s *= ATTN_SCALE; S[i] = s; mx = fmaxf(mx, s);
    }
    mx = wave_max(mx);
    float sum = 0.f;
    for (int i = lane; i < nt; i += 64) { const float p = __expf(S[i] - mx); S[i] = p; sum += p; }
    sum = wave_sum(sum);
    __builtin_amdgcn_s_waitcnt(0);
    float o0 = 0.f, o1 = 0.f;
    for (int i = 0; i < nt; ++i) {
        const int kvr = i < n1 ? base1 + i : base2 + (i - n1);
        const bf16_t* v = kv_row(kp.Vp, kp.Vs, kp.Vt, kvr) + h * VD + 2 * lane;
        const unsigned vv = *(const unsigned*)v; const float p = S[i];
        o0 += p * __uint_as_float(vv << 16); o1 += p * __uint_as_float(vv & 0xffff0000u);
    }
    const float il = 1.f / sum;
    bf16_t* O = (bf16_t*)(P.ws + WS_E) + (size_t)r * D + h * VD + 2 * lane;
    *(unsigned*)O = (unsigned)f2bf(o0 * il) | ((unsigned)f2bf(o1 * il) << 16);
}

template <class Epi>
static void gemm_simple(hipStream_t st, const bf16_t* A, int lda, const bf16_t* Bt, int ldb, int M, int N, int K, Epi E) {
    hipLaunchKernelGGL(k_gemm_simple<Epi>, dim3((N + 15) / 16, (M + 15) / 16), dim3(256), 0, st, A, lda, Bt, ldb, M, N, K, E);
}
extern "C" void kernel_launch(void* const* d_in, const int* in_sizes, int n_in, void* d_out, int out_size, void* d_ws, size_t ws_size, hipStream_t stream) {
    if (n_in != 34 || out_size != (int)OO_END || ws_size < 256 * MiB) { fprintf(stderr, "kernel_launch: unexpected shapes n_in %d out %d ws %zu\n", n_in, out_size, ws_size); return; }
    Params P{};
    for (int i = 0; i < 34; ++i) P.in[i] = (const float*)d_in[i];
    P.out = (float*)d_out; P.ws = (unsigned char*)d_ws;
    unsigned char* ws = P.ws;
    bf16_t *Win = (bf16_t*)(ws + WS_WIN), *Wuq = (bf16_t*)(ws + WS_WUQ), *Wukv = (bf16_t*)(ws + WS_WUKV), *Wo = (bf16_t*)(ws + WS_WO), *Wglu = (bf16_t*)(ws + WS_WGLU),
           *Wout = (bf16_t*)(ws + WS_WOUT), *Wup = (bf16_t*)(ws + WS_WUP), *Wdn = (bf16_t*)(ws + WS_WDN);
    bf16_t *GA = (bf16_t*)(ws + WS_GA), *GB = (bf16_t*)(ws + WS_GB), *E_ = (bf16_t*)(ws + WS_E), *ZQ = (bf16_t*)(ws + WS_ZQ), *U = (bf16_t*)(ws + WS_U), *CQ = (bf16_t*)(ws + WS_CQ),
           *CALL = (bf16_t*)(ws + WS_CALL), *KR = (bf16_t*)(ws + WS_KR), *QM = (bf16_t*)(ws + WS_QM), *QT = (bf16_t*)(ws + WS_QT), *KT = (bf16_t*)(ws + WS_KT), *VT = (bf16_t*)(ws + WS_VT),
           *VS = (bf16_t*)(ws + WS_VS), *A1T = (bf16_t*)(ws + WS_A1T), *A1M = (bf16_t*)(ws + WS_A1M);
    bf16_t *KP = (bf16_t*)(P.out + OO_Y), *VP = KP + (size_t)TM * D, *KS = KP;
    hipLaunchKernelGGL(k_transpose, dim3(2048), dim3(256), 0, stream, P.in[10], (const float*)nullptr, Win, D, INC, INCP, 0);
    hipLaunchKernelGGL(k_transpose, dim3(1024), dim3(256), 0, stream, P.in[12], (const float*)nullptr, Wuq, QL, NH * QKD, NH * QKD, 0);
    hipLaunchKernelGGL(k_transpose, dim3(1024), dim3(256), 0, stream, P.in[17], (const float*)nullptr, Wukv, KVL, 2048, 2048, 0);
    hipLaunchKernelGGL(k_transpose, dim3(1024), dim3(256), 0, stream, P.in[19], (const float*)nullptr, Wo, D, D, D, 0);
    hipLaunchKernelGGL(k_transpose, dim3(1024), dim3(256), 0, stream, P.in[28], P.in[29], Wglu, D, D, 2 * D, 1);
    hipLaunchKernelGGL(k_transpose, dim3(1024), dim3(256), 0, stream, P.in[30], (const float*)nullptr, Wout, D, D, D, 0);
    hipLaunchKernelGGL(k_transpose, dim3(2048), dim3(256), 0, stream, P.in[32], (const float*)nullptr, Wup, D, DFF, DFF, 0);
    hipLaunchKernelGGL(k_transpose, dim3(2048), dim3(256), 0, stream, P.in[33], (const float*)nullptr, Wdn, DFF, D, D, 0);
    hipLaunchKernelGGL(k_rope_table, dim3((LP * 32 + 255) / 256), dim3(256), 0, stream, (float*)(ws + WS_ROPE));
    hipLaunchKernelGGL(k_cache_prep, dim3(2048), dim3(256), 0, stream, P);
    hipLaunchKernelGGL(k_xn, dim3(T / 4), dim3(256), 0, stream, P);
    gemm_simple(stream, E_, D, Win, D, T, INCP, D, EpiG1{ZQ, U, GA, GB});
    hipLaunchKernelGGL(k_norm1, dim3(T / 4), dim3(256), 0, stream, P);
    hipLaunchKernelGGL(k_ssm_direct, dim3(NB * NG + DB * NG), dim3(64), 0, stream, P);
    gemm_simple(stream, CQ, QL, Wuq, QL, T, NH * QKD, QL, EpiQ{QM, QT});
    hipLaunchKernelGGL(k_qnorm, dim3(T * NH / 4), dim3(256), 0, stream, P);
    gemm_simple(stream, E_, D, Wglu, D, TOUT, D, D, EpiGlu{GB});
    gemm_simple(stream, CALL, KVL, Wukv, KVL, TM, 2048, KVL, EpiKV{KP, VP});
    gemm_simple(stream, CALL + (size_t)KV_T0 * KVL, KVL, Wukv, KVL, KVT, 2048, KVL, EpiKV{KT, VT});
    hipLaunchKernelGGL(k_knorm, dim3(TM * NH / 4), dim3(256), 0, stream, KP, TM, P.in[18]);
    hipLaunchKernelGGL(k_knorm, dim3(KVT * NH / 4), dim3(256), 0, stream, KT, KVT, P.in[18]);
    KvPtrs kp{KP, VP, KS, VS, KT, VT, KR};
    hipLaunchKernelGGL(k_attn_simple, dim3(TM * NH / 2), dim3(128), 0, stream, P, kp, 0, TM);
    hipLaunchKernelGGL(k_attn_simple, dim3(NB * NMETA * NH / 2), dim3(128), 0, stream, P, kp, TMETA0, T);
    gemm_simple(stream, CALL + (size_t)KV_SC0 * KVL, KVL, Wukv, KVL, DB * PAST, 2048, KVL, EpiKV{KS, VS});
    hipLaunchKernelGGL(k_knorm, dim3(DB * PAST * NH / 4), dim3(256), 0, stream, KS, DB * PAST, P.in[18]);
    hipLaunchKernelGGL(k_attn_simple, dim3(TS * NH / 2), dim3(128), 0, stream, P, kp, TS0, TMETA0);
    gemm_simple(stream, E_, D, Wo, D, TOUT, D, D, EpiMerge{GA, GB});
    gemm_simple(stream, GA, D, Wout, D, TOUT, D, D, EpiH1{P});
    hipLaunchKernelGGL(k_xn2, dim3(TOUT / 4), dim3(256), 0, stream, P);
    gemm_simple(stream, GA, D, Wup, D, TOUT, DFF, D, EpiUp{A1M, A1T});
    gemm_simple(stream, A1M, DFF, Wdn, DFF, TM, D, DFF, EpiDown{P.out + OO_Y});
    gemm_simple(stream, A1T, DFF, Wdn, DFF, TS, D, DFF, EpiDown{P.out + OO_YS});
}
```

```cpp
#include <hip/hip_runtime.h>
#include <hip/hip_cooperative_groups.h>
namespace cg = cooperative_groups;
#include <cstdio>
#include <cstdint>

typedef unsigned short bf16_t;
typedef short bf16x8 __attribute__((ext_vector_type(8)));
typedef float f32x4 __attribute__((ext_vector_type(4)));

constexpr int D = 1024, NB = 4, SEQ = 4096, DB = 16, DS = 32, PAST = 2048;
constexpr int NMETA = 16, NH = 8, NOPE = 128, ROPE = 64, VD = 128, QKD = 192, QL = 384, KVL = 256;
constexpr int NG = 64, GS = 16, NS = 64, DFF = 4096;
constexpr int INC = 3776, O_KV = 384, O_KR = 640, O_SSM = 704, O_GA = 1728, O_GB = 2752, INCP = 3840;
constexpr float EPS = 1e-6f;
constexpr float ATTN_SCALE = 0.07216878364870322f;
constexpr int LP = NMETA + SEQ;

constexpr int TPAD = 67 * 256;
constexpr int TM = NB * SEQ, TS0 = TM, TS = DB * DS, TMETA0 = TS0 + TS, T = TMETA0 + NB * NMETA, TOUT = TMETA0;
constexpr int KV_SC0 = TM, KV_T0 = KV_SC0 + DB * PAST, KV_PM0 = KV_T0, KV_ST0 = KV_T0 + NB * 64, KVR = KV_ST0 + DB * 64, KVT = KVR - KV_T0;

constexpr size_t OO_Y = 0, OO_YS = OO_Y + (size_t)NB * SEQ * D, OO_LATP = OO_YS + (size_t)DB * DS * D, OO_KRP = OO_LATP + (size_t)NB * SEQ * KVL,
                 OO_MLAT = OO_KRP + (size_t)NB * SEQ * ROPE, OO_MKR = OO_MLAT + (size_t)NB * NMETA * KVL, OO_SREP = OO_MKR + (size_t)NB * NMETA * ROPE,
                 OO_SIMP = OO_SREP + (size_t)NB * NG * NS, OO_LATS = OO_SIMP + (size_t)NB * NG * NS, OO_KRS = OO_LATS + (size_t)DB * DS * KVL,
                 OO_SRES = OO_KRS + (size_t)DB * DS * ROPE, OO_SIMS = OO_SRES + (size_t)DB * NG * NS, OO_END = OO_SIMS + (size_t)DB * NG * NS;
static_assert(OO_END == 22892544, "output size");

constexpr size_t MiB = 1u << 20;
constexpr size_t TB = (size_t)T * D * 2;
constexpr size_t WS_BAR = 1 * MiB;
constexpr size_t WS_GKQ = WS_BAR + 32 * 1024;
constexpr size_t WS_P2 = WS_BAR + 128 * 1024, WS_P2T = WS_P2 + (size_t)TM * 4 * 4;
static_assert(WS_P2T + (size_t)TS * 16 * 4 <= 2 * MiB, "control region");
constexpr size_t WS_OLAT = 210 * MiB;
constexpr size_t WS_WP = 197 * MiB;
constexpr size_t WS_WIN = 2 * MiB, WS_WUQ = WS_WIN + (size_t)INCP * D * 2, WS_WUKV = WS_WUQ + (size_t)NH * QKD * QL * 2, WS_WO = WS_WUKV + (size_t)2048 * KVL * 2,
                 WS_WGLU = WS_WO + (size_t)D * D * 2, WS_WOUT = WS_WGLU + (size_t)2 * D * D * 2, WS_WUP = WS_WOUT + (size_t)D * D * 2, WS_WDN = WS_WUP + (size_t)DFF * D * 2,
                 WS_WEND = WS_WDN + (size_t)DFF * D * 2;
static_assert(WS_WEND <= 36 * MiB, "weights");
constexpr size_t WS_WUKK = 1 * MiB + 512 * 1024;
constexpr size_t WS_CF = WS_WOUT;
static_assert(WS_CF + (size_t)DB * PAST * KVL * 2 <= WS_WEND, "CF");
constexpr size_t WS_IKT = 197 * MiB;
constexpr size_t WS_IK = 196 * MiB;
constexpr size_t WS_WUKVB = 0;
static_assert(WS_WUKVB + (size_t)KVL * 2048 * 2 <= 1 * MiB, "wukv copy");
constexpr size_t WS_ROPE = 36 * MiB;
constexpr size_t WS_KR = 37 * MiB + 512 * 1024;
static_assert(WS_ROPE + (size_t)LP * 32 * 2 * 4 <= WS_KR && WS_KR + (size_t)KVR * ROPE * 2 <= 44 * MiB, "small region");
constexpr size_t WS_GA = 44 * MiB, WS_GB = 78 * MiB, WS_E = 112 * MiB;
static_assert(WS_GA + TB <= WS_GB && WS_GB + TB <= WS_E && WS_E + TB <= 146 * MiB, "T buffers");
constexpr size_t WS_F = 146 * MiB;
constexpr size_t WS_ZQ = WS_F, WS_U = WS_ZQ + (size_t)T * O_SSM * 2, WS_CQ = WS_U + TB, WS_CALL = 231 * MiB;
static_assert(WS_CQ + (size_t)T * QL * 2 <= 215 * MiB && WS_CALL + (size_t)KVR * KVL * 2 <= 256 * MiB, "F region P1-P2");
constexpr size_t WS_QM = WS_F;
static_assert(WS_QM + (size_t)TM * NH * QKD * 2 <= WS_CQ, "Qmain vs CQ");
constexpr size_t WS_MATS = 215 * MiB;
constexpr size_t WS_KTAB = WS_MATS, WS_QTAB = WS_KTAB + (size_t)NG * 16 * 256 * 2, WS_PTAB = WS_QTAB + (size_t)NG * 256 * 128 * 2, WS_L16 = WS_PTAB + (size_t)NG * 128 * 256 * 2;
static_assert(WS_L16 + (size_t)NG * NS * 8 <= 231 * MiB, "ssm tables");
constexpr size_t WS_KT = 215 * MiB, WS_VT = WS_KT + (size_t)KVT * D * 2, WS_QT = WS_VT + (size_t)KVT * D * 2;
static_assert(WS_QT + (size_t)(T - TM) * NH * QKD * 2 <= WS_CALL, "tail region");
constexpr size_t WS_VS = WS_F;
static_assert(WS_VS + (size_t)DB * PAST * D * 2 <= WS_KT, "Vs");
constexpr size_t WS_A1T = WS_E, WS_A1M = 128 * MiB;
static_assert(WS_A1T + (size_t)TS * DFF * 2 <= WS_A1M && WS_A1M + (size_t)TM * DFF * 2 <= 256 * MiB, "A1");

__device__ __forceinline__ float bf2f(bf16_t v) { return __uint_as_float((unsigned)v << 16); }
__device__ __forceinline__ bf16_t f2bf(float f) { unsigned u = __float_as_uint(f); return (bf16_t)((u + 0x7fffu + ((u >> 16) & 1u)) >> 16); }
__device__ __forceinline__ float wave_sum(float v) {
#pragma unroll
    for (int o = 1; o < 64; o <<= 1) v += __shfl_xor(v, o);
    return v;
}
__device__ __forceinline__ float wave_max(float v) {
#pragma unroll
    for (int o = 1; o < 64; o <<= 1) v = fmaxf(v, __shfl_xor(v, o));
    return v;
}
__device__ __forceinline__ float sigmoidf_(float x) { const float e = __expf(fminf(-x, 80.f)); return fmaf(-e, __builtin_amdgcn_rcpf(1.f + e), 1.f); }
__device__ __forceinline__ float gelu_tanh(float x) { const float u = 0.7978845608028654f * (x + 0.044715f * x * x * x); return 0.5f * x * (1.f + tanhf(u)); }
__device__ __forceinline__ int row_pos(int r) { return r < TM ? (r & (SEQ - 1)) : (r < TMETA0 ? PAST + ((r - TS0) & (DS - 1)) : ((r - TMETA0) & (NMETA - 1)) - NMETA); }
__device__ __forceinline__ int row_kvr(int r) {
    if (r < TM) return r;
    if (r < TMETA0) { const int s = r - TS0; return KV_ST0 + (s >> 5) * 64 + (s & 31); }
    const int s = r - TMETA0; return KV_PM0 + (s >> 4) * 64 + (s & 15);
}

constexpr int LDS_TOP = 163840, TIDTAB_OFF = LDS_TOP - 16 - 256;
__device__ __forceinline__ unsigned hw_slot() { return (unsigned)__builtin_amdgcn_s_getreg((5 << 11) | 4) & 63u; }
__device__ __forceinline__ int my_tid() {
    const int w = *(volatile __attribute__((address_space(3))) int*)(uintptr_t)(TIDTAB_OFF + hw_slot() * 4);
    int l; asm volatile("v_mbcnt_lo_u32_b32 %0, -1, 0\n\tv_mbcnt_hi_u32_b32 %0, -1, %0" : "=v"(l));
    return __builtin_amdgcn_readfirstlane(w) * 64 + l;
}
struct Params {
    const float* in[34];
    float* out;
    unsigned char* ws;
};

namespace pg8 {
#define PG8_LAS __attribute__((address_space(3)))
typedef unsigned short bf16_t;
typedef short bf16x8 __attribute__((ext_vector_type(8)));
typedef float f32x4 __attribute__((ext_vector_type(4)));
typedef unsigned u32x4 __attribute__((ext_vector_type(4)));
constexpr int BM = 256, BK = 64, HALF = 128, HTB = HALF * BK * 2  , STAGE_BYTES = 8 * HTB, NXCD = 8, WGM = 8;

__host__ __device__ __forceinline__ int lds_byte(int r, int c) { const int st = (r >> 4) * 2 + (c >> 5), rr = r & 15, cc = c & 31, ob = rr * 64 + cc * 2; return st * 1024 + (ob ^ (((ob >> 9) & 1) << 5)); }
__host__ __device__ __forceinline__ void stage_rc(int b, int& R, int& C) { const int st = b / 1024, sb = b % 1024, swz = sb ^ (((sb >> 9) & 1) << 5); R = (st >> 1) * 16 + swz / 64; C = (st & 1) * 32 + (swz % 64) / 2; }
__host__ __device__ __forceinline__ int perm32(int rho) { const int n = rho >> 4, i = rho & 15; return 8 * (i >> 2) + 4 * n + (i & 3); }

struct Unit { int pm, pn; };
struct Gemm { const bf16_t* A; const bf16_t* Bt; int M, N, K; };

struct StaticOrder {
    int nM, nN, nwg, G, c;
    __host__ __device__ void init(int M, int N, int G_, int c_) { nM = M / BM; nN = N / BM; nwg = nM * nN; G = G_; c = c_; }
    __host__ __device__ bool next(int i, Unit& u) const {
        const long L = (long)i * G + c; if (L >= nwg) return false;
        int wgid = (int)L; { const int q = nwg / NXCD, r = nwg % NXCD, xcd = wgid % NXCD, off = wgid / NXCD; wgid = (xcd < r ? xcd * (q + 1) : r * (q + 1) + (xcd - r) * q) + off; }
        const int nig = WGM * nN, gid = wgid / nig, fm = gid * WGM, gsz = (nM - fm) < WGM ? (nM - fm) : WGM;
        u.pm = fm + ((wgid % nig) % gsz); u.pn = (wgid % nig) / gsz; return true;
    }
    __device__ __forceinline__ void a_ready(const Unit&) const {}
    __device__ __forceinline__ void done(const Unit&) const {}
};


__device__ __forceinline__ unsigned cvt_pk_bf16(float lo, float hi) { unsigned r; asm volatile("v_cvt_pk_bf16_f32 %0, %1, %2" : "=v"(r) : "v"(lo), "v"(hi)); return r; }
template <class Epi, class Sched, bool ALIGN_EPI = false, bool SP2 = false>
__device__ __forceinline__ void gemm_phase(PG8_LAS unsigned char* lds, const Gemm g, const Sched& S, const Epi& E) {
    int tid_ = my_tid(); asm volatile("" : "+v"(tid_));
    const int tid = tid_, wid = __builtin_amdgcn_readfirstlane(tid >> 6), lane = tid & 63, wr = wid >> 2, wc = wid & 3, fr = lane & 15, fq = lane >> 4;
    int K_ = g.K; asm volatile("" : "+s"(K_));
    const int K = K_, nt = K / BK;
    unsigned voffA[2], voffB[2];
#pragma unroll
    for (int i = 0; i < 2; ++i) { int R, C; stage_rc(tid * 16 + i * 8192, R, C); const int Rb = Epi::PERM ? ((R & ~31) + perm32(R & 31)) : R;
        voffA[i] = (unsigned)(R * K + C) * 2u; voffB[i] = (unsigned)(Rb * K + C) * 2u; }
    const size_t kstep = (size_t)(BK * 2);
    const size_t hstep = (size_t)HALF * K * 2;
    const size_t tstep = 2 * hstep;
    const unsigned ldsw = (unsigned)wid * 1024u;
    const int aoff = lds_byte(wr * 64 + fr, fq * 8), boff = lds_byte(wc * 32 + fr, fq * 8);
#define PG8_SA(b, h) (((b) * 2 + (h)) * HTB)
#define PG8_SB(b, h) ((4 + (b) * 2 + (h)) * HTB)
#define PG8_STAGE(bufoff, gbase, voff) do { _Pragma("unroll") for (int _i = 0; _i < 2; ++_i) \
        __builtin_amdgcn_global_load_lds((const unsigned*)((const char*)(gbase) + (voff)[_i]), (PG8_LAS unsigned*)(lds + (bufoff) + ldsw + _i * 8192), 16, 0, 0); } while (0)
#define PG8_LDA(dst, b, h) do { _Pragma("unroll") for (int m = 0; m < 4; ++m) _Pragma("unroll") for (int k = 0; k < 2; ++k) dst[m][k] = *(const PG8_LAS bf16x8*)(lds + PG8_SA(b, h) + aoff + m * 2048 + k * 1024); } while (0)
#define PG8_LDB(dst, b, h) do { _Pragma("unroll") for (int n = 0; n < 2; ++n) _Pragma("unroll") for (int k = 0; k < 2; ++k) dst[n][k] = *(const PG8_LAS bf16x8*)(lds + PG8_SB(b, h) + boff + n * 2048 + k * 1024); } while (0)
#define PG8_MMA(ai, bj, At, Bt) do { __builtin_amdgcn_s_setprio(1); _Pragma("unroll") for (int m = 0; m < 4; ++m) _Pragma("unroll") for (int n = 0; n < 2; ++n) _Pragma("unroll") for (int k = 0; k < 2; ++k) \
        acc[ai][bj][m][n] = __builtin_amdgcn_mfma_f32_16x16x32_bf16(Bt[n][k], At[m][k], acc[ai][bj][m][n], 0, 0, 0); __builtin_amdgcn_s_setprio(0); } while (0)
#define PG8_WAIT_V(n) asm volatile("s_waitcnt vmcnt(" #n ")" ::: "memory")
#define PG8_WAIT_L(n) asm volatile("s_waitcnt lgkmcnt(" #n ")" ::: "memory")
#define PG8_BAR __builtin_amdgcn_s_barrier()
#define PG8_SCHED __builtin_amdgcn_sched_barrier(0)
    Unit cur, nxt; int ui = 0;
    if (!S.next(0, cur)) return;
    f32x4 acc[2][2][4][2];
#pragma unroll
    for (int a = 0; a < 2; ++a)
#pragma unroll
        for (int b = 0; b < 2; ++b)
#pragma unroll
            for (int m = 0; m < 4; ++m)
#pragma unroll
                for (int n = 0; n < 2; ++n) acc[a][b][m][n] = (f32x4){0.f, 0.f, 0.f, 0.f};
    bf16x8 At[4][2], B0[2][2], B1[2][2];
    const char* cA = (const char*)g.A + (size_t)cur.pm * tstep; const char* cB = (const char*)g.Bt + (size_t)cur.pn * tstep;
    S.a_ready(cur);
    if constexpr (SP2) {
        PG8_STAGE(PG8_SB(0, 0), cB, voffB); PG8_STAGE(PG8_SB(0, 1), cB + hstep, voffB); PG8_STAGE(PG8_SA(0, 0), cA, voffA); PG8_STAGE(PG8_SA(0, 1), cA + hstep, voffA);
        if (wr == 1) PG8_BAR;
        PG8_WAIT_V(2); PG8_BAR;
        PG8_STAGE(PG8_SB(1, 0), cB + kstep, voffB); PG8_STAGE(PG8_SA(1, 0), cA + kstep, voffA); PG8_STAGE(PG8_SB(1, 1), cB + hstep + kstep, voffB);
        PG8_WAIT_V(6); PG8_BAR;
    } else {
        PG8_STAGE(PG8_SB(0, 0), cB, voffB); PG8_STAGE(PG8_SA(0, 0), cA, voffA); PG8_STAGE(PG8_SB(0, 1), cB + hstep, voffB); PG8_STAGE(PG8_SA(0, 1), cA + hstep, voffA);
        if (wr == 1) PG8_BAR;
        PG8_WAIT_V(4); PG8_BAR;
        PG8_STAGE(PG8_SB(1, 0), cB + kstep, voffB); PG8_STAGE(PG8_SA(1, 0), cA + kstep, voffA); PG8_STAGE(PG8_SB(1, 1), cB + hstep + kstep, voffB);
        PG8_WAIT_V(6); PG8_BAR;
    }
    for (;;) {
        const bool has_next = S.next(ui + 1, nxt);
        const char* nA = has_next ? (const char*)g.A + (size_t)nxt.pm * tstep : cA; const char* nB = has_next ? (const char*)g.Bt + (size_t)nxt.pn * tstep : cB;
        for (int t = 0; t < nt; t += 2) {
            const bool last = (t == nt - 2);
            const char* a1 = cA + (size_t)(t + 1) * kstep;
            const char* a2 = last ? nA : cA + (size_t)(t + 2) * kstep; const char* b2 = last ? nB : cB + (size_t)(t + 2) * kstep;
            const char* a3 = a2 + kstep; const char* b3 = b2 + kstep;
            if (last && has_next) S.a_ready(nxt);
            if constexpr (SP2) {
            PG8_LDB(B0, 0, 0); PG8_LDB(B1, 0, 1); PG8_SCHED; PG8_LDA(At, 0, 0); PG8_STAGE(PG8_SA(1, 1), a1 + hstep, voffA);
            PG8_WAIT_V(8); PG8_WAIT_L(0); PG8_BAR; PG8_MMA(0, 0, At, B0); PG8_MMA(0, 1, At, B1); PG8_BAR; PG8_SCHED;
            PG8_LDA(At, 0, 1); PG8_STAGE(PG8_SB(0, 0), b2, voffB); PG8_STAGE(PG8_SB(0, 1), b2 + hstep, voffB); PG8_STAGE(PG8_SA(0, 0), a2, voffA);
            PG8_WAIT_V(8); PG8_WAIT_L(0); PG8_BAR; PG8_MMA(1, 0, At, B0); PG8_MMA(1, 1, At, B1); PG8_BAR; PG8_SCHED;
            PG8_LDB(B0, 1, 0); PG8_LDB(B1, 1, 1); PG8_SCHED; PG8_LDA(At, 1, 0); PG8_STAGE(PG8_SA(0, 1), a2 + hstep, voffA);
            PG8_WAIT_V(8); PG8_WAIT_L(0); PG8_BAR; PG8_MMA(0, 0, At, B0); PG8_MMA(0, 1, At, B1); PG8_BAR; PG8_SCHED;
            PG8_LDA(At, 1, 1); PG8_STAGE(PG8_SB(1, 0), b3, voffB); PG8_STAGE(PG8_SB(1, 1), b3 + hstep, voffB); PG8_STAGE(PG8_SA(1, 0), a3, voffA);
            PG8_WAIT_V(8); PG8_WAIT_L(0); PG8_BAR; PG8_MMA(1, 0, At, B0); PG8_MMA(1, 1, At, B1); PG8_BAR; PG8_SCHED;
            } else {
            PG8_LDB(B0, 0, 0); PG8_SCHED; PG8_LDA(At, 0, 0); PG8_STAGE(PG8_SA(1, 1), a1 + hstep, voffA);
            PG8_WAIT_L(8); PG8_BAR; PG8_WAIT_L(0); PG8_MMA(0, 0, At, B0); PG8_BAR; PG8_SCHED;
            PG8_LDB(B1, 0, 1); PG8_STAGE(PG8_SB(0, 0), b2, voffB);
            PG8_BAR; PG8_WAIT_L(0); PG8_MMA(0, 1, At, B1); PG8_BAR;
            PG8_LDA(At, 0, 1); PG8_STAGE(PG8_SA(0, 0), a2, voffA);
            PG8_BAR; PG8_WAIT_L(0); PG8_MMA(1, 0, At, B0); PG8_BAR; PG8_SCHED;
            PG8_STAGE(PG8_SB(0, 1), b2 + hstep, voffB);
            PG8_WAIT_V(6); PG8_BAR; PG8_MMA(1, 1, At, B1); PG8_BAR;
            PG8_LDB(B0, 1, 0); PG8_SCHED; PG8_LDA(At, 1, 0); PG8_STAGE(PG8_SA(0, 1), a2 + hstep, voffA);
            PG8_WAIT_L(8); PG8_BAR; PG8_WAIT_L(0); PG8_MMA(0, 0, At, B0); PG8_BAR; PG8_SCHED;
            PG8_LDB(B1, 1, 1); PG8_STAGE(PG8_SB(1, 0), b3, voffB);
            PG8_BAR; PG8_WAIT_L(0); PG8_MMA(0, 1, At, B1); PG8_BAR;
            PG8_LDA(At, 1, 1); PG8_STAGE(PG8_SA(1, 0), a3, voffA);
            PG8_BAR; PG8_WAIT_L(0); PG8_MMA(1, 0, At, B0); PG8_BAR; PG8_SCHED;
            PG8_STAGE(PG8_SB(1, 1), b3 + hstep, voffB);
            PG8_WAIT_V(6); PG8_BAR; PG8_MMA(1, 1, At, B1); PG8_BAR;
            }
        }
        if constexpr (ALIGN_EPI) { if (wr == 0) PG8_BAR; }
        if constexpr (!Epi::AFTER_DRAIN) { E(acc, cur, wr, wc, fr, fq); S.done(cur); }
        if (!has_next) break;
#pragma unroll
        for (int a = 0; a < 2; ++a)
#pragma unroll
            for (int b = 0; b < 2; ++b)
#pragma unroll
                for (int m = 0; m < 4; ++m)
#pragma unroll
                    for (int n = 0; n < 2; ++n) acc[a][b][m][n] = (f32x4){0.f, 0.f, 0.f, 0.f};
        cur = nxt; cA = nA; cB = nB; ++ui;
        if constexpr (ALIGN_EPI) { if (wr == 1) PG8_BAR; }
    }
    PG8_WAIT_V(0);
    if constexpr (!ALIGN_EPI) { if (wr == 0) PG8_BAR; }
    PG8_BAR;
    if constexpr (Epi::AFTER_DRAIN) { E.fused(acc, cur, wr, wc, fr, fq, lds, wid, lane); S.done(cur); }
#undef PG8_SA
#undef PG8_SB
#undef PG8_STAGE
#undef PG8_LDA
#undef PG8_LDB
#undef PG8_MMA
#undef PG8_WAIT_V
#undef PG8_WAIT_L
#undef PG8_BAR
#undef PG8_SCHED
}
}

constexpr int NTHR = 512, NWV = NTHR / 64;
constexpr int LDS_BYTES = 163840;
namespace att {
typedef __attribute__((address_space(3))) unsigned char lds_t;
using s16x4  = __attribute__((ext_vector_type(4))) short;
using f32x16 = __attribute__((ext_vector_type(16))) float;
using u32x4  = __attribute__((ext_vector_type(4))) unsigned;
#define ATT_SBAR() __builtin_amdgcn_sched_barrier(0)
constexpr float THR = 8.f;
constexpr int VBUF = 16384, KBUF = 24576, NVB = 4, NKB = 3, OFF_V = 0, OFF_K = NVB * VBUF, OFF_KN = 0, OFF_KR = 16384, OFF_WS = OFF_K + NKB * KBUF, LDS_NEED = OFF_WS + NWV * 256;
__device__ __forceinline__ int crow(int r, int hi) { return (r & 3) + 8 * (r >> 2) + 4 * hi; }
__device__ __forceinline__ unsigned cvtpk(float lo, float hi) { unsigned r; asm volatile("v_cvt_pk_bf16_f32 %0, %1, %2" : "=v"(r) : "v"(lo), "v"(hi)); return r; }
__device__ __forceinline__ int kn_off(int row, int c16) { return row * 256 + ((c16 ^ (row & 15)) << 4); }
__device__ __forceinline__ int kr_off(int row, int c16) { return row * 128 + ((c16 ^ ((row >> 1) & 7)) << 4); }
__device__ __forceinline__ int v_st(int k, int c) { const int kk = (k & ~0xC) | ((k & 4) << 1) | ((k & 8) >> 1); return ((kk >> 3) * 4 + (c >> 5)) * 512 + ((kk & 7) * 32 + (c & 31)) * 2; }
__device__ __forceinline__ int v_rd_base(int lane) { return ((lane & 3) << 3) | (((lane >> 2) & 3) << 6) | (((lane >> 4) & 1) << 5) | (((lane >> 5) & 1) << 8); }
constexpr int v_rd_off(int d0, int ks, int half) { return d0 * 512 + ks * 4096 + half * 2048; }
template <int OFF> __device__ __forceinline__ s16x4 tr_read(unsigned vb) { s16x4 r; asm volatile("ds_read_b64_tr_b16 %0, %1 offset:%2" : "=&v"(r) : "v"(vb), "i"(OFF) : "memory"); return r; }

__device__ __forceinline__ void partialSM(f32x16& p0, f32x16& p1, float& m_reg, float& alpha) {
    constexpr float C = ATTN_SCALE * 1.4426950408889634f;
    float ma = fmaxf(p0[0], p0[1]), mb = fmaxf(p0[2], p0[3]), mc = fmaxf(p1[0], p1[1]), md = fmaxf(p1[2], p1[3]);
#pragma unroll
    for (int r = 4; r < 16; r += 4) { ma = fmaxf(ma, fmaxf(p0[r], p0[r + 1])); mb = fmaxf(mb, fmaxf(p0[r + 2], p0[r + 3])); mc = fmaxf(mc, fmaxf(p1[r], p1[r + 1])); md = fmaxf(md, fmaxf(p1[r + 2], p1[r + 3])); }
    float pmax = fmaxf(fmaxf(ma, mb), fmaxf(mc, md));
    { auto rr = __builtin_amdgcn_permlane32_swap(__float_as_uint(pmax), __float_as_uint(pmax), false, false); pmax = fmaxf(__uint_as_float(rr[0]), __uint_as_float(rr[1])); }
    float mn;
    if (__all(pmax - m_reg <= THR / ATTN_SCALE)) { mn = m_reg; alpha = 1.f; }
    else { mn = fmaxf(m_reg, pmax); alpha = __builtin_amdgcn_exp2f((m_reg - mn) * C); m_reg = mn; }
    const float mnC = -mn * C;
#pragma unroll
    for (int r = 0; r < 16; ++r) { p0[r] = __builtin_amdgcn_exp2f(fmaf(p0[r], C, mnC)); p1[r] = __builtin_amdgcn_exp2f(fmaf(p1[r], C, mnC)); }
}
__device__ __forceinline__ void finishSM(const f32x16& p0, const f32x16& p1, float alpha, float& l_reg, bf16x8& pa0, bf16x8& pa1, bf16x8& pa2, bf16x8& pa3) {
    float sa = p0[0] + p0[1], sb = p0[2] + p0[3], sc = p1[0] + p1[1], sd = p1[2] + p1[3];
#pragma unroll
    for (int r = 4; r < 16; r += 4) { sa += p0[r] + p0[r + 1]; sb += p0[r + 2] + p0[r + 3]; sc += p1[r] + p1[r + 1]; sd += p1[r + 2] + p1[r + 3]; }
    float ps = (sa + sb) + (sc + sd);
    { auto rr = __builtin_amdgcn_permlane32_swap(__float_as_uint(ps), __float_as_uint(ps), false, false); ps = __uint_as_float(rr[0]) + __uint_as_float(rr[1]); }
    l_reg = l_reg * alpha + ps;
#define ATT_PK4(P, BASE, OUT) do { unsigned a0 = cvtpk(P[BASE + 0], P[BASE + 1]), a1 = cvtpk(P[BASE + 2], P[BASE + 3]);   \
    unsigned b0 = cvtpk(P[BASE + 4], P[BASE + 5]), b1 = cvtpk(P[BASE + 6], P[BASE + 7]);                              \
    auto r0 = __builtin_amdgcn_permlane32_swap(a0, b0, false, false); auto r1 = __builtin_amdgcn_permlane32_swap(a1, b1, false, false); \
    u32x4 w = {r0[0], r1[0], r0[1], r1[1]}; OUT = __builtin_bit_cast(bf16x8, w); } while (0)
    ATT_PK4(p0, 0, pa0); ATT_PK4(p0, 8, pa1); ATT_PK4(p1, 0, pa2); ATT_PK4(p1, 8, pa3);
#undef ATT_PK4
}
#define ATT_KRD2(d0_, d1_, addr, OFFB) asm volatile("ds_read_b128 %0, %2\n\tds_read_b128 %1, %2 offset:" #OFFB : "=&v"(d0_), "=&v"(d1_) : "v"(addr))
__device__ __forceinline__ void qkt(f32x16& p0, f32x16& p1, lds_t* buf, const bf16x8 (&qr)[12], int r32, int hi) {
    p0 = f32x16{}; p1 = f32x16{};
    const unsigned kb = (unsigned)(uintptr_t)buf;
    const unsigned x = r32 & 15, nb0 = kb + OFF_KN + r32 * 256 + ((hi ^ (x & 1)) << 4), na = (x >> 1) << 5;
    const unsigned rb0 = kb + OFF_KR + r32 * 128, ra = ((r32 >> 1) & 7) << 4, rh = hi << 4;
#define ATT_KADDR(step) ((step) < 8 ? nb0 + (na ^ (unsigned)((step) << 5)) : rb0 + (ra ^ ((unsigned)(((step) - 8) << 5) | rh)))
    bf16x8 f0[3], f1[3];
    ATT_KRD2(f0[0], f1[0], ATT_KADDR(0), 8192); ATT_KRD2(f0[1], f1[1], ATT_KADDR(1), 8192);
#pragma unroll
    for (int d0 = 0; d0 < 12; ++d0) {
        if (d0 + 2 < 12) { if (d0 + 2 < 8) ATT_KRD2(f0[(d0 + 2) % 3], f1[(d0 + 2) % 3], ATT_KADDR(d0 + 2), 8192); else ATT_KRD2(f0[(d0 + 2) % 3], f1[(d0 + 2) % 3], ATT_KADDR(d0 + 2), 4096); }
        if (d0 <= 9) asm volatile("s_waitcnt lgkmcnt(4)" ::: "memory"); else if (d0 == 10) asm volatile("s_waitcnt lgkmcnt(2)" ::: "memory"); else asm volatile("s_waitcnt lgkmcnt(0)" ::: "memory");
        ATT_SBAR();
        p0 = __builtin_amdgcn_mfma_f32_32x32x16_bf16(f0[d0 % 3], qr[d0], p0, 0, 0, 0);
        p1 = __builtin_amdgcn_mfma_f32_32x32x16_bf16(f1[d0 % 3], qr[d0], p1, 0, 0, 0);
    }
#undef ATT_KADDR
}
template <int D0> __device__ __forceinline__ void pv_one(f32x16& od, unsigned vb, bf16x8 pa0, bf16x8 pa1, bf16x8 pa2, bf16x8 pa3) {
    const s16x4 l0 = tr_read<v_rd_off(D0, 0, 0)>(vb), h0 = tr_read<v_rd_off(D0, 0, 1)>(vb), l1 = tr_read<v_rd_off(D0, 1, 0)>(vb), h1 = tr_read<v_rd_off(D0, 1, 1)>(vb);
    const s16x4 l2 = tr_read<v_rd_off(D0, 2, 0)>(vb), h2 = tr_read<v_rd_off(D0, 2, 1)>(vb), l3 = tr_read<v_rd_off(D0, 3, 0)>(vb), h3 = tr_read<v_rd_off(D0, 3, 1)>(vb);
    asm volatile("s_waitcnt lgkmcnt(0)" ::: "memory"); ATT_SBAR();
#define ATT_PK(L, H) (bf16x8){L[0], L[1], L[2], L[3], H[0], H[1], H[2], H[3]}
    od = __builtin_amdgcn_mfma_f32_32x32x16_bf16(pa0, ATT_PK(l0, h0), od, 0, 0, 0);
    od = __builtin_amdgcn_mfma_f32_32x32x16_bf16(pa1, ATT_PK(l1, h1), od, 0, 0, 0);
    od = __builtin_amdgcn_mfma_f32_32x32x16_bf16(pa2, ATT_PK(l2, h2), od, 0, 0, 0);
    od = __builtin_amdgcn_mfma_f32_32x32x16_bf16(pa3, ATT_PK(l3, h3), od, 0, 0, 0);
#undef ATT_PK
}

template <class T> __device__ __forceinline__ T* uni_ptr(T* p) { const unsigned long long v = (unsigned long long)p; const unsigned lo = __builtin_amdgcn_readfirstlane((unsigned)v), hi = __builtin_amdgcn_readfirstlane((unsigned)(v >> 32)); return (T*)(((unsigned long long)hi << 32) | lo); }
template <class T> __device__ __forceinline__ T* opq_ptr(T* p) { asm volatile("" : "+s"(p)); return p; }
__device__ __forceinline__ int uni_int(int v) { return __builtin_amdgcn_readfirstlane(v); }
struct Unit {
    const bf16_t* Q; bf16_t* O;
    const bf16_t *K0, *V0, *KR0, *K1, *V1, *KR1; int n0, n1;
    int jm, nv;
    int nact, lim0, lstep;
    int raw0, raw1;
    int pos0;
    const float *gqn, *gqr, *gkn, *rtab;
    unsigned* cnt; const bf16_t* WV; bf16_t* O2;
    const float* IK1;
    const float* IK0; const bf16_t* WB;
};
__device__ __forceinline__ float xsum32(float v) { auto rr = __builtin_amdgcn_permlane32_swap(__float_as_uint(v), __float_as_uint(v), false, false); return __uint_as_float(rr[0]) + __uint_as_float(rr[1]); }
__device__ __forceinline__ void load_q(const Unit& U, const bf16_t* Qw, int pos, int hi, bf16x8 (&qr)[12]) {
#pragma unroll
        for (int d0 = 0; d0 < 12; ++d0) qr[d0] = *(const bf16x8*)(Qw + d0 * 16);
        const float* tb = U.rtab + ((size_t)(pos + NMETA) * 32 + hi * 8) * 2;
        f32x4 tv[2][4], ga[2][2], gb[2][2];
#pragma unroll
        for (int dd = 0; dd < 2; ++dd) {
#pragma unroll
            for (int i = 0; i < 4; ++i) tv[dd][i] = *(const f32x4*)(tb + dd * 32 + i * 4);
            ga[dd][0] = *(const f32x4*)(U.gqr + dd * 16 + hi * 8); ga[dd][1] = *(const f32x4*)(U.gqr + dd * 16 + hi * 8 + 4);
            gb[dd][0] = *(const f32x4*)(U.gqr + 32 + dd * 16 + hi * 8); gb[dd][1] = *(const f32x4*)(U.gqr + 32 + dd * 16 + hi * 8 + 4); }
        float sn = 0.f, sr_ = 0.f;
#pragma unroll
        for (int d0 = 0; d0 < 12; ++d0)
#pragma unroll
            for (int e = 0; e < 8; ++e) { const float v = bf2f((bf16_t)qr[d0][e]); if (d0 < 8) sn += v * v; else sr_ += v * v; }
        sn = xsum32(sn); sr_ = xsum32(sr_);
        const float rn = rsqrtf(sn * (1.f / NOPE) + EPS), rr = rsqrtf(sr_ * (1.f / ROPE) + EPS);
#pragma unroll
        for (int d0 = 0; d0 < 8; ++d0) { u32x4 w;
            w.x = cvtpk(bf2f((bf16_t)qr[d0][0]) * rn, bf2f((bf16_t)qr[d0][1]) * rn); w.y = cvtpk(bf2f((bf16_t)qr[d0][2]) * rn, bf2f((bf16_t)qr[d0][3]) * rn);
            w.z = cvtpk(bf2f((bf16_t)qr[d0][4]) * rn, bf2f((bf16_t)qr[d0][5]) * rn); w.w = cvtpk(bf2f((bf16_t)qr[d0][6]) * rn, bf2f((bf16_t)qr[d0][7]) * rn);
            qr[d0] = __builtin_bit_cast(bf16x8, w); }
#pragma unroll
        for (int dd = 0; dd < 2; ++dd) {
            float lo[8], hh[8];
#pragma unroll
            for (int e = 0; e < 8; ++e) {
                const float ya = bf2f((bf16_t)qr[8 + dd][e]) * rr * ga[dd][e >> 2][e & 3], yb = bf2f((bf16_t)qr[10 + dd][e]) * rr * gb[dd][e >> 2][e & 3];
                const float c = tv[dd][e >> 1][(e & 1) * 2], s = tv[dd][e >> 1][(e & 1) * 2 + 1];
                lo[e] = ya * c - yb * s; hh[e] = yb * c + ya * s; }
            u32x4 wl, wh; wl.x = cvtpk(lo[0], lo[1]); wl.y = cvtpk(lo[2], lo[3]); wl.z = cvtpk(lo[4], lo[5]); wl.w = cvtpk(lo[6], lo[7]);
            wh.x = cvtpk(hh[0], hh[1]); wh.y = cvtpk(hh[2], hh[3]); wh.z = cvtpk(hh[4], hh[5]); wh.w = cvtpk(hh[6], hh[7]);
            qr[8 + dd] = __builtin_bit_cast(bf16x8, wl); qr[10 + dd] = __builtin_bit_cast(bf16x8, wh); }
}
__device__ __forceinline__ void run_unit(const Unit& U_, lds_t* lds) {
    Unit U;
    U.Q = uni_ptr(U_.Q); U.O = uni_ptr(U_.O); U.K0 = uni_ptr(U_.K0); U.V0 = uni_ptr(U_.V0); U.KR0 = uni_ptr(U_.KR0); U.K1 = uni_ptr(U_.K1); U.V1 = uni_ptr(U_.V1); U.KR1 = uni_ptr(U_.KR1);
    U.n0 = uni_int(U_.n0); U.n1 = uni_int(U_.n1); U.jm = uni_int(U_.jm); U.nv = uni_int(U_.nv); U.nact = uni_int(U_.nact); U.lim0 = uni_int(U_.lim0); U.lstep = uni_int(U_.lstep);
    U.raw0 = uni_int(U_.raw0); U.raw1 = uni_int(U_.raw1); U.pos0 = uni_int(U_.pos0); U.gqn = uni_ptr(U_.gqn); U.gqr = uni_ptr(U_.gqr); U.gkn = uni_ptr(U_.gkn); U.rtab = uni_ptr(U_.rtab);
    int tid_ = my_tid(); asm volatile("" : "+v"(tid_));
    const int tid = tid_, wid = __builtin_amdgcn_readfirstlane(tid >> 6), lane = tid & 63, r32 = lane & 31, hi = lane >> 5;
    const int NT = U.n0 + U.n1;
    const int lim = wid < U.nact ? U.lim0 + (wid >> 1) * U.lstep : 0;
    __attribute__((address_space(3))) float* al_l = (__attribute__((address_space(3))) float*)(lds + OFF_WS + wid * 256);
    __attribute__((address_space(3))) float* li_l = al_l + 32;
    float m_reg = -1e30f, l_reg = 0.f; f32x16 o[4] = {}; bf16x8 qr[12];
    const int sr = tid >> 4, sc = (tid & 15) * 8, kr_r = tid >> 3, kr_c = tid & 7;
    const int vst0 = v_st(sr, sc), vst1 = v_st(32 + sr, sc), kst0 = kn_off(sr, sc >> 3), kst1 = kn_off(32 + sr, sc >> 3), krst = kr_off(kr_r, kr_c);
    const unsigned vb0 = (unsigned)(uintptr_t)(lds + OFF_V) + (unsigned)v_rd_base(lane);
    bf16x8 sk0, sk1, sv0, sv1, skr;
#define ATT_SLOAD(j) do { const int j_ = (j); const bool s0_ = j_ < U.n0; const size_t ro_ = (size_t)(s0_ ? j_ : j_ - U.n0) * 64; \
        const bf16_t* Kt_ = (s0_ ? U.K0 : U.K1) + ro_ * D; const bf16_t* Vt_ = (s0_ ? U.V0 : U.V1) + ro_ * D; const bf16_t* Rt_ = (s0_ ? U.KR0 : U.KR1) + ro_ * ROPE; \
        sk0 = *(const bf16x8*)(Kt_ + (size_t)sr * D + sc); sk1 = *(const bf16x8*)(Kt_ + (size_t)(32 + sr) * D + sc); \
        sv0 = *(const bf16x8*)(Vt_ + (size_t)sr * D + sc); sv1 = *(const bf16x8*)(Vt_ + (size_t)(32 + sr) * D + sc); \
        skr = *(const bf16x8*)(Rt_ + (size_t)kr_r * ROPE + kr_c * 8); } while (0)
#define ATT_KNORM(kx) do { float f_[8]; float ss_ = 0.f; _Pragma("unroll") for (int e = 0; e < 8; ++e) { f_[e] = bf2f((bf16_t)kx[e]); ss_ += f_[e] * f_[e]; } \
        ss_ += __shfl_xor(ss_, 1); ss_ += __shfl_xor(ss_, 2); ss_ += __shfl_xor(ss_, 4); ss_ += __shfl_xor(ss_, 8); const float rs_ = rsqrtf(ss_ * (1.f / NOPE) + EPS); \
        u32x4 w_; w_.x = cvtpk(f_[0] * rs_ * U.gkn[sc + 0], f_[1] * rs_ * U.gkn[sc + 1]); w_.y = cvtpk(f_[2] * rs_ * U.gkn[sc + 2], f_[3] * rs_ * U.gkn[sc + 3]); \
        w_.z = cvtpk(f_[4] * rs_ * U.gkn[sc + 4], f_[5] * rs_ * U.gkn[sc + 5]); w_.w = cvtpk(f_[6] * rs_ * U.gkn[sc + 6], f_[7] * rs_ * U.gkn[sc + 7]); kx = __builtin_bit_cast(bf16x8, w_); } while (0)
#define ATT_SWRITE(vb_, kb_, j) do { lds_t* V_ = lds + OFF_V + (vb_) * VBUF; lds_t* K_ = lds + OFF_K + (kb_) * KBUF; if (((j) < U.n0) ? U.raw0 : U.raw1) { ATT_KNORM(sk0); ATT_KNORM(sk1); } \
        *(__attribute__((address_space(3))) bf16x8*)(V_ + vst0) = sv0; *(__attribute__((address_space(3))) bf16x8*)(V_ + vst1) = sv1; \
        *(__attribute__((address_space(3))) bf16x8*)(K_ + OFF_KN + kst0) = sk0; *(__attribute__((address_space(3))) bf16x8*)(K_ + OFF_KN + kst1) = sk1; \
        *(__attribute__((address_space(3))) bf16x8*)(K_ + OFF_KR + krst) = skr; } while (0)
    const int dsl0 = wid * 64 + lane, dsl1 = 512 + dsl0;
    unsigned gk0, gk1, gv0, gv1, gkr;
    { const int r0_ = dsl0 >> 4, r1_ = dsl1 >> 4; gk0 = (unsigned)(r0_ * D + (((dsl0 & 15) ^ (r0_ & 15)) << 3)); gk1 = (unsigned)(r1_ * D + (((dsl1 & 15) ^ (r1_ & 15)) << 3));
      const int rr_ = dsl0 >> 3; gkr = (unsigned)(rr_ * ROPE + (((dsl0 & 7) ^ ((rr_ >> 1) & 7)) << 3));
      auto vsrc = [](int s) { const int sub = s >> 5, within = s & 31, kk = (sub >> 2) * 8 + (within >> 2), k = (kk & ~0xC) | ((kk & 4) << 1) | ((kk & 8) >> 1), c = (sub & 3) * 32 + (within & 3) * 8; return (unsigned)(k * D + c); };
      gv0 = vsrc(dsl0); gv1 = vsrc(dsl1); }
#define ATT_DMA(vb_, kb_, j) do { const int j_ = (j); const bool s0_ = j_ < U.n0; const size_t ro_ = (size_t)(s0_ ? j_ : j_ - U.n0) * 64; \
        const bf16_t* Kt_ = (s0_ ? U.K0 : U.K1) + ro_ * D; const bf16_t* Vt_ = (s0_ ? U.V0 : U.V1) + ro_ * D; const bf16_t* Rt_ = (s0_ ? U.KR0 : U.KR1) + ro_ * ROPE; \
        lds_t* V_ = lds + OFF_V + (vb_) * VBUF + wid * 1024; lds_t* K_ = lds + OFF_K + (kb_) * KBUF + wid * 1024; \
        __builtin_amdgcn_global_load_lds((const unsigned*)(Kt_ + gk0), (__attribute__((address_space(3))) unsigned*)(K_ + OFF_KN), 16, 0, 0); \
        __builtin_amdgcn_global_load_lds((const unsigned*)(Kt_ + gk1), (__attribute__((address_space(3))) unsigned*)(K_ + OFF_KN + 8192), 16, 0, 0); \
        __builtin_amdgcn_global_load_lds((const unsigned*)(Vt_ + gv0), (__attribute__((address_space(3))) unsigned*)(V_), 16, 0, 0); \
        __builtin_amdgcn_global_load_lds((const unsigned*)(Vt_ + gv1), (__attribute__((address_space(3))) unsigned*)(V_ + 8192), 16, 0, 0); \
        __builtin_amdgcn_global_load_lds((const unsigned*)(Rt_ + gkr), (__attribute__((address_space(3))) unsigned*)(K_ + OFF_KR), 16, 0, 0); } while (0)
    const bool roleB = wid >= 4;
    bf16x8 pa0 = {}, pa1 = {}, pa2 = {}, pa3 = {};
    __syncthreads();
    ATT_SLOAD(0);
    if (1 < NT) ATT_DMA(1, 1, 1);
    if (lim > 0) {
        load_q(U, U.Q + (size_t)(wid * 32 + r32) * (NH * QKD) + hi * 8, U.pos0 + wid * 32 + r32, hi, qr);
    } else {
#pragma unroll
        for (int d0 = 0; d0 < 12; ++d0) qr[d0] = bf16x8{};
    }
    ATT_SWRITE(0, 0, 0);
    asm volatile("s_waitcnt vmcnt(0) lgkmcnt(0)" ::: "memory"); __builtin_amdgcn_s_barrier(); asm volatile("" ::: "memory");
    int kcur = 0;
    for (int jj = 0; jj <= NT; ++jj) {
        const int vcur = jj & 3, vprv = (jj - 1) & 3, k2 = kcur == 0 ? 2 : kcur - 1;
        if (jj + 2 < NT) ATT_DMA((jj + 2) & 3, k2, jj + 2);
        const bool doQK = jj < NT && jj < lim;
        if (roleB && jj >= 1 && jj - 1 < lim) { const unsigned vb = vb0 + (unsigned)(vprv * VBUF); __builtin_amdgcn_s_setprio(1);
            pv_one<0>(o[0], vb, pa0, pa1, pa2, pa3); pv_one<1>(o[1], vb, pa0, pa1, pa2, pa3); pv_one<2>(o[2], vb, pa0, pa1, pa2, pa3); pv_one<3>(o[3], vb, pa0, pa1, pa2, pa3); __builtin_amdgcn_s_setprio(0); }
        if (doQK) {
            f32x16 p0, p1; float alpha;
            __builtin_amdgcn_s_setprio(1); qkt(p0, p1, lds + OFF_K + kcur * KBUF, qr, r32, hi); __builtin_amdgcn_s_setprio(0);
            if (jj == U.jm) { const int kb_ = 4 * hi;
#pragma unroll
                for (int r = 0; r < 16; ++r) { const int kv = kb_ + (r & 3) + 8 * (r >> 2); if (kv >= U.nv) p0[r] = -INFINITY; if (kv + 32 >= U.nv) p1[r] = -INFINITY; } }
            partialSM(p0, p1, m_reg, alpha);
            if (__any(alpha < 1.f)) {
                if (hi == 0) al_l[r32] = alpha;
                asm volatile("s_waitcnt lgkmcnt(0)" ::: "memory");
#pragma unroll
                for (int r = 0; r < 16; ++r) { const float a = al_l[crow(r, hi)];
#pragma unroll
                    for (int d = 0; d < 4; ++d) o[d][r] *= a; }
            }
            finishSM(p0, p1, alpha, l_reg, pa0, pa1, pa2, pa3);
        }
        if (!roleB && doQK) { const unsigned vb = vb0 + (unsigned)(vcur * VBUF); __builtin_amdgcn_s_setprio(1);
            pv_one<0>(o[0], vb, pa0, pa1, pa2, pa3); pv_one<1>(o[1], vb, pa0, pa1, pa2, pa3); pv_one<2>(o[2], vb, pa0, pa1, pa2, pa3); pv_one<3>(o[3], vb, pa0, pa1, pa2, pa3); __builtin_amdgcn_s_setprio(0); }
        if (jj + 2 < NT) asm volatile("s_waitcnt vmcnt(5) lgkmcnt(0)" ::: "memory"); else asm volatile("s_waitcnt vmcnt(0) lgkmcnt(0)" ::: "memory");
        __builtin_amdgcn_s_barrier(); asm volatile("" ::: "memory");
        kcur = kcur == 2 ? 0 : kcur + 1;
    }
    if (lim > 0) {
        int hi_e = hi, r32_e = r32; asm volatile("" : "+v"(hi_e), "+v"(r32_e));
        if (hi_e == 0) li_l[r32_e] = l_reg;
        asm volatile("s_waitcnt lgkmcnt(0)" ::: "memory");
        __attribute__((address_space(3))) bf16_t* OL = (__attribute__((address_space(3))) bf16_t*)(lds + OFF_V + wid * 8192);
#pragma unroll
        for (int r = 0; r < 16; ++r) { const int orow = crow(r, hi_e); const float rl = __builtin_amdgcn_rcpf(li_l[orow]);
#pragma unroll
            for (int d0 = 0; d0 < 4; ++d0) OL[orow * 128 + d0 * 32 + r32_e] = f2bf(o[d0][r] * rl); }
        asm volatile("s_waitcnt lgkmcnt(0)" ::: "memory");
        bf16_t* Ow = U.O + (size_t)(wid * 32) * D;
#pragma unroll
        for (int q = 0; q < 8; ++q) { const int s16 = q * 64 + r32_e + 32 * hi_e, orow = s16 >> 4, oc = (s16 & 15) * 8;
            *(bf16x8*)(Ow + (size_t)orow * D + oc) = *(const __attribute__((address_space(3))) bf16x8*)(OL + orow * 128 + oc); }
    }
#undef ATT_SLOAD
#undef ATT_SWRITE
#undef ATT_KNORM
#undef ATT_DMA
}
__device__ __forceinline__ void acc_frags(const f32x16& p, bf16x8& f0, bf16x8& f1) {
#define ATT_PK4(P, BASE, OUT) do { unsigned a0 = cvtpk(P[BASE + 0], P[BASE + 1]), a1 = cvtpk(P[BASE + 2], P[BASE + 3]);   \
    unsigned b0 = cvtpk(P[BASE + 4], P[BASE + 5]), b1 = cvtpk(P[BASE + 6], P[BASE + 7]);                              \
    auto r0 = __builtin_amdgcn_permlane32_swap(a0, b0, false, false); auto r1 = __builtin_amdgcn_permlane32_swap(a1, b1, false, false); \
    u32x4 w = {r0[0], r1[0], r0[1], r1[1]}; OUT = __builtin_bit_cast(bf16x8, w); } while (0)
    ATT_PK4(p, 0, f0); ATT_PK4(p, 8, f1);
#undef ATT_PK4
}
__device__ __forceinline__ void run_sample_unit(const Unit& U_, lds_t* lds, int vhalf) {
    Unit U;
    U.Q = uni_ptr(U_.Q); U.O = uni_ptr(U_.O); U.K0 = uni_ptr(U_.K0); U.V0 = uni_ptr(U_.V0); U.KR0 = uni_ptr(U_.KR0); U.K1 = uni_ptr(U_.K1); U.V1 = uni_ptr(U_.V1); U.KR1 = uni_ptr(U_.KR1);
    U.n0 = uni_int(U_.n0); U.n1 = uni_int(U_.n1); U.jm = uni_int(U_.jm); U.nv = uni_int(U_.nv); U.pos0 = uni_int(U_.pos0);
    U.gqn = opq_ptr(U_.gqn); U.gqr = opq_ptr(U_.gqr); U.gkn = opq_ptr(U_.gkn); U.rtab = opq_ptr(U_.rtab); U.IK0 = uni_ptr(U_.IK0); U.WB = uni_ptr(U_.WB); U.IK1 = uni_ptr(U_.IK1); U.cnt = uni_ptr(U_.cnt); U.WV = uni_ptr(U_.WV); U.O2 = uni_ptr(U_.O2);
    int tid_ = my_tid(); asm volatile("" : "+v"(tid_));
    const int tid = tid_, wid = __builtin_amdgcn_readfirstlane(tid >> 6), lane = tid & 63, r32 = lane & 31, hi = lane >> 5;
    const int NT = U.n0 + U.n1;
    constexpr float C = ATTN_SCALE * 1.4426950408889634f;
    lds_t* myV = lds + wid * 16384;
    __attribute__((address_space(3))) float* al_l = (__attribute__((address_space(3))) float*)(lds + 131072 + wid * 256);
    __attribute__((address_space(3))) float* ML = (__attribute__((address_space(3))) float*)(lds + 131072 + NWV * 256);
    __attribute__((address_space(3))) float* iks = (__attribute__((address_space(3))) float*)(lds + 131072 + 4096 + wid * 512);
    lds_t* QL = lds + 131072 + 9216;
    const unsigned vb = (unsigned)(uintptr_t)myV + (unsigned)v_rd_base(lane);
    float m_reg = -1e30f, l_reg = 0.f; f32x16 o[4] = {};
    {
        bf16x8 qn[12];
        load_q(U, U.Q + (size_t)r32 * (NH * QKD) + hi * 8, U.pos0 + r32, hi, qn);
        const bf16_t* wb = U.WB + (size_t)(wid * 32 + r32) * 2048 + hi * 8;
        f32x16 a = {};
#pragma unroll
        for (int s = 0; s < 8; ++s) a = __builtin_amdgcn_mfma_f32_32x32x16_bf16(*(const bf16x8*)(wb + s * 16), qn[s], a, 0, 0, 0);
        asm volatile("s_nop 15\n\ts_nop 7" : "+v"(a));
        bf16x8 f0, f1; acc_frags(a, f0, f1);
        __syncthreads();
        *(__attribute__((address_space(3))) bf16x8*)(QL + (2 * wid) * 1024 + lane * 16) = f0; *(__attribute__((address_space(3))) bf16x8*)(QL + (2 * wid + 1) * 1024 + lane * 16) = f1;
        if (wid < 4) *(__attribute__((address_space(3))) bf16x8*)(QL + (16 + wid) * 1024 + lane * 16) = wid == 0 ? qn[8] : wid == 1 ? qn[9] : wid == 2 ? qn[10] : qn[11];
    }
    __syncthreads();
    const unsigned gvb = (unsigned)(((((lane & 31) >> 2) & 3) + ((((lane & 31) >> 4) & 1) << 3)) * KVL + hi * 32 + (lane & 3) * 8) + (unsigned)(vhalf * 128);
    const __attribute__((address_space(3))) bf16x8* qf = (const __attribute__((address_space(3))) bf16x8*)(QL + lane * 16);
    for (int j = wid; j < NT; j += NWV) {
        const bool s0 = j < U.n0; const size_t ro = (size_t)(s0 ? j : j - U.n0) * 64;
        const bf16_t* Cb = (s0 ? U.V0 : U.V1) + ro * KVL; const bf16_t* Rt = (s0 ? U.KR0 : U.KR1) + ro * ROPE;
        const int kst = s0 ? 1024 : 16;
        const bf16_t* kb0 = s0 ? U.K0 + ro * 256 : Cb; const bf16_t* kb1 = s0 ? kb0 + 512 : kb0 + (size_t)32 * KVL; const unsigned ko = s0 ? (unsigned)(hi * 256 + r32 * 8) : (unsigned)(r32 * KVL + hi * 8);
        const bf16_t* rb0 = Rt; const bf16_t* rb1 = s0 ? Rt + 512 : Rt + (size_t)32 * ROPE; const unsigned rof = s0 ? (unsigned)(hi * 256 + r32 * 8) : (unsigned)(r32 * ROPE + hi * 8);
        float rs0, rs1;
        if (s0) { rs0 = U.IK0[ro + r32]; rs1 = U.IK0[ro + 32 + r32]; }
        else { const float* t0 = U.IK1 + (size_t)(ro + r32) * 16; const float a0 = t0[0] + t0[1], a1 = t0[32 * 16] + t0[32 * 16 + 1];
            rs0 = rsqrtf(a0 * (1.f / NOPE) + EPS); rs1 = rsqrtf(a1 * (1.f / NOPE) + EPS); }
        bf16x8 xr0[4], xr1[4], xa0[8], xa1[8];
#pragma unroll
        for (int d0 = 0; d0 < 4; ++d0) { xr0[d0] = *(const bf16x8*)(rb0 + d0 * kst + rof); xr1[d0] = *(const bf16x8*)(rb1 + d0 * kst + rof); }
#pragma unroll
        for (int d0 = 0; d0 < 8; ++d0) { xa0[d0] = *(const bf16x8*)(kb0 + d0 * kst + ko); xa1[d0] = *(const bf16x8*)(kb1 + d0 * kst + ko); }
#pragma unroll
        for (int i = 0; i < 16; ++i)
            __builtin_amdgcn_global_load_lds((const unsigned*)(Cb + gvb + (16 * (i >> 2) + 4 * ((i >> 1) & 1)) * KVL + (i & 1) * 64), (__attribute__((address_space(3))) unsigned*)(myV + i * 1024), 16, 0, 0);
        ATT_SBAR();
        if (hi == 0) { iks[r32] = rs0; iks[32 + r32] = rs1; iks[64 + r32] = __builtin_amdgcn_rcpf(rs0); iks[96 + r32] = __builtin_amdgcn_rcpf(rs1); }
        f32x16 p0 = {}, p1 = {};
#pragma unroll
        for (int d0 = 0; d0 < 4; ++d0) { const bf16x8 q = qf[(16 + d0) * 64]; p0 = __builtin_amdgcn_mfma_f32_32x32x16_bf16(xr0[d0], q, p0, 0, 0, 0); p1 = __builtin_amdgcn_mfma_f32_32x32x16_bf16(xr1[d0], q, p1, 0, 0, 0); }
        ATT_SBAR();
        bf16x8 xb0[4], xb1[4];
#pragma unroll
        for (int d0 = 0; d0 < 4; ++d0) { xb0[d0] = *(const bf16x8*)(kb0 + (8 + d0) * kst + ko); xb1[d0] = *(const bf16x8*)(kb1 + (8 + d0) * kst + ko); }
        ATT_SBAR();
#pragma unroll
        for (int g = 0; g < 4; ++g) { const f32x4 i0 = *(const __attribute__((address_space(3))) f32x4*)(iks + 64 + 8 * g + 4 * hi), i1 = *(const __attribute__((address_space(3))) f32x4*)(iks + 96 + 8 * g + 4 * hi);
#pragma unroll
            for (int i = 0; i < 4; ++i) { p0[4 * g + i] *= i0[i]; p1[4 * g + i] *= i1[i]; } }
#pragma unroll
        for (int d0 = 0; d0 < 4; ++d0) { const bf16x8 q = qf[d0 * 64]; p0 = __builtin_amdgcn_mfma_f32_32x32x16_bf16(xa0[d0], q, p0, 0, 0, 0); p1 = __builtin_amdgcn_mfma_f32_32x32x16_bf16(xa1[d0], q, p1, 0, 0, 0); }
        ATT_SBAR();
        bf16x8 xc0[4], xc1[4];
#pragma unroll
        for (int d0 = 0; d0 < 4; ++d0) { xc0[d0] = *(const bf16x8*)(kb0 + (12 + d0) * kst + ko); xc1[d0] = *(const bf16x8*)(kb1 + (12 + d0) * kst + ko); }
        ATT_SBAR();
#pragma unroll
        for (int d0 = 4; d0 < 8; ++d0) { const bf16x8 q = qf[d0 * 64]; p0 = __builtin_amdgcn_mfma_f32_32x32x16_bf16(xa0[d0], q, p0, 0, 0, 0); p1 = __builtin_amdgcn_mfma_f32_32x32x16_bf16(xa1[d0], q, p1, 0, 0, 0); }
#pragma unroll
        for (int d0 = 0; d0 < 4; ++d0) { const bf16x8 q = qf[(8 + d0) * 64]; p0 = __builtin_amdgcn_mfma_f32_32x32x16_bf16(xb0[d0], q, p0, 0, 0, 0); p1 = __builtin_amdgcn_mfma_f32_32x32x16_bf16(xb1[d0], q, p1, 0, 0, 0); }
#pragma unroll
        for (int d0 = 0; d0 < 4; ++d0) { const bf16x8 q = qf[(12 + d0) * 64]; p0 = __builtin_amdgcn_mfma_f32_32x32x16_bf16(xc0[d0], q, p0, 0, 0, 0); p1 = __builtin_amdgcn_mfma_f32_32x32x16_bf16(xc1[d0], q, p1, 0, 0, 0); }
#pragma unroll
        for (int g = 0; g < 4; ++g) { const f32x4 i0 = *(const __attribute__((address_space(3))) f32x4*)(iks + 8 * g + 4 * hi), i1 = *(const __attribute__((address_space(3))) f32x4*)(iks + 32 + 8 * g + 4 * hi);
#pragma unroll
            for (int i = 0; i < 4; ++i) { p0[4 * g + i] *= i0[i]; p1[4 * g + i] *= i1[i]; } }
        if (j == U.jm) { const int kb = 4 * hi;
#pragma unroll
            for (int r = 0; r < 16; ++r) { const int kv = kb + (r & 3) + 8 * (r >> 2); if (kv >= U.nv) p0[r] = -INFINITY; if (kv + 32 >= U.nv) p1[r] = -INFINITY; } }
        float alpha; bf16x8 pa0, pa1, pa2, pa3;
        partialSM(p0, p1, m_reg, alpha);
        if (__any(alpha < 1.f)) {
            if (hi == 0) al_l[r32] = alpha;
            asm volatile("s_waitcnt lgkmcnt(0)" ::: "memory");
#pragma unroll
            for (int r = 0; r < 16; ++r) { const float a = al_l[crow(r, hi)];
#pragma unroll
                for (int d = 0; d < 4; ++d) o[d][r] *= a; }
        }
        finishSM(p0, p1, alpha, l_reg, pa0, pa1, pa2, pa3);
        asm volatile("s_waitcnt vmcnt(0) lgkmcnt(0)" ::: "memory");
        pv_one<0>(o[0], vb, pa0, pa1, pa2, pa3); pv_one<1>(o[1], vb, pa0, pa1, pa2, pa3); pv_one<2>(o[2], vb, pa0, pa1, pa2, pa3); pv_one<3>(o[3], vb, pa0, pa1, pa2, pa3);
    }
    {
        int hi_e = hi, r32_e = r32; asm volatile("" : "+v"(hi_e), "+v"(r32_e));
        __attribute__((address_space(3))) float* OP = (__attribute__((address_space(3))) float*)myV;
        asm volatile("s_waitcnt lgkmcnt(0)" ::: "memory");
#pragma unroll
        for (int r = 0; r < 16; ++r)
#pragma unroll
            for (int d0 = 0; d0 < 4; ++d0) OP[crow(r, hi_e) * 128 + d0 * 32 + r32_e] = o[d0][r];
        if (hi_e == 0) { ML[(wid * 32 + r32_e) * 2] = m_reg; ML[(wid * 32 + r32_e) * 2 + 1] = l_reg; }
    }
    __syncthreads();
    {
        const int row = tid >> 4, c0 = (tid & 15) * 8;
        float M = -1e30f;
#pragma unroll
        for (int w = 0; w < NWV; ++w) M = fmaxf(M, ML[(w * 32 + row) * 2]);
        float L = 0.f; float acc[8] = {0.f, 0.f, 0.f, 0.f, 0.f, 0.f, 0.f, 0.f};
#pragma unroll
        for (int w = 0; w < NWV; ++w) { const float wg = __builtin_amdgcn_exp2f((ML[(w * 32 + row) * 2] - M) * C); L += wg * ML[(w * 32 + row) * 2 + 1];
            const __attribute__((address_space(3))) float* op = (const __attribute__((address_space(3))) float*)(lds + w * 16384) + row * 128 + c0;
            const f32x4 a = *(const __attribute__((address_space(3))) f32x4*)op, b = *(const __attribute__((address_space(3))) f32x4*)(op + 4);
            acc[0] += wg * a[0]; acc[1] += wg * a[1]; acc[2] += wg * a[2]; acc[3] += wg * a[3]; acc[4] += wg * b[0]; acc[5] += wg * b[1]; acc[6] += wg * b[2]; acc[7] += wg * b[3]; }
        const float il = 1.f / L;
        u32x4 w; w.x = cvtpk(acc[0] * il, acc[1] * il); w.y = cvtpk(acc[2] * il, acc[3] * il); w.z = cvtpk(acc[4] * il, acc[5] * il); w.w = cvtpk(acc[6] * il, acc[7] * il);
        *(u32x4*)(U.O + (size_t)row * 2048 + vhalf * 128 + c0) = w;
    }
    {
        __attribute__((address_space(3))) unsigned* tk = (__attribute__((address_space(3))) unsigned*)(lds + 131072 + 8192);
        asm volatile("s_waitcnt vmcnt(0)" ::: "memory");
        __syncthreads();
        if (tid == 0) { __builtin_amdgcn_fence(__ATOMIC_RELEASE, "agent"); asm volatile("s_waitcnt vmcnt(0)" ::: "memory");
                        *tk = __hip_atomic_fetch_add(U.cnt, 1u, __ATOMIC_RELAXED, __HIP_MEMORY_SCOPE_AGENT); }
        __syncthreads();
        const unsigned ticket = *tk;
        if (ticket == 1u && wid < 4) {
            __builtin_amdgcn_fence(__ATOMIC_ACQUIRE, "agent");
            int hi_e = hi, r32_e = r32; asm volatile("" : "+v"(hi_e), "+v"(r32_e));
            const bf16_t* wv = U.WV + (size_t)(32 * wid + r32_e) * KVL + hi_e * 8; const bf16_t* ol = U.O + (size_t)r32_e * 2048 + hi_e * 8;
            f32x16 acc = {};
#pragma unroll
            for (int s = 0; s < 16; ++s) acc = __builtin_amdgcn_mfma_f32_32x32x16_bf16(*(const bf16x8*)(wv + s * 16), *(const bf16x8*)(ol + s * 16), acc, 0, 0, 0);
            asm volatile("s_nop 15\n\ts_nop 7" : "+v"(acc));
            bf16_t* op = U.O2 + (size_t)r32_e * D + 32 * wid + 4 * hi_e;
#pragma unroll
            for (int g = 0; g < 4; ++g) { uint2 w2; w2.x = cvtpk(acc[4 * g], acc[4 * g + 1]); w2.y = cvtpk(acc[4 * g + 2], acc[4 * g + 3]); *(uint2*)(op + 8 * g) = w2; }
        }
    }
}
}

typedef unsigned u32x4_t __attribute__((ext_vector_type(4)));
typedef float f32x2_t __attribute__((ext_vector_type(2)));
__device__ __forceinline__ u32x4_t pack8(const f32x4 a, const f32x4 b) { u32x4_t w; w.x = pg8::cvt_pk_bf16(a[0], a[1]); w.y = pg8::cvt_pk_bf16(a[2], a[3]); w.z = pg8::cvt_pk_bf16(b[0], b[1]); w.w = pg8::cvt_pk_bf16(b[2], b[3]); return w; }
__device__ __forceinline__ void unpack8(const u32x4_t w, f32x4& a, f32x4& b) {
    a[0] = __uint_as_float(w.x << 16); a[1] = __uint_as_float(w.x & 0xffff0000u); a[2] = __uint_as_float(w.y << 16); a[3] = __uint_as_float(w.y & 0xffff0000u);
    b[0] = __uint_as_float(w.z << 16); b[1] = __uint_as_float(w.z & 0xffff0000u); b[2] = __uint_as_float(w.w << 16); b[3] = __uint_as_float(w.w & 0xffff0000u); }
__device__ __forceinline__ float rowsum4(float v) {
    { auto a = __builtin_amdgcn_permlane16_swap(__float_as_uint(v), __float_as_uint(v), false, false); v = __uint_as_float(a[0]) + __uint_as_float(a[1]); }
    { auto b = __builtin_amdgcn_permlane32_swap(__float_as_uint(v), __float_as_uint(v), false, false); v = __uint_as_float(b[0]) + __uint_as_float(b[1]); }
    return v; }
__device__ __forceinline__ f32x4 sig4(const f32x4 x) { f32x4 r; r[0] = sigmoidf_(x[0]); r[1] = sigmoidf_(x[1]); r[2] = sigmoidf_(x[2]); r[3] = sigmoidf_(x[3]); return r; }
#define LAS __attribute__((address_space(3)))
#define XB_TMO      128
#define XB_XCNT(j)  (256  + 64 * (j))
#define XB_XSUB(j)  (1280 + 64 * (j))
#define XB_XGEN(j)  (2304 + 64 * (j))
#define XB_TOP      3328
#define XB_TOPGEN   3392
#define XCD_BAR_WORDS 3456
#define XB_SPIN_CAP (1u << 18)

__device__ __forceinline__ unsigned xb_ld(unsigned* p)              { return __hip_atomic_load(p, __ATOMIC_RELAXED, __HIP_MEMORY_SCOPE_AGENT); }
__device__ __forceinline__ unsigned xb_add(unsigned* p, unsigned v) { return __hip_atomic_fetch_add(p, v, __ATOMIC_RELAXED, __HIP_MEMORY_SCOPE_AGENT); }
__device__ __forceinline__ unsigned xb_xcc_id() { return (unsigned)__builtin_amdgcn_s_getreg((3 << 11) | 20) & 0xFu; }
#define XB_SPIN(cond, bar) do { unsigned _sp = 0; while (cond) { __builtin_amdgcn_s_sleep(1); \
    if ((++_sp & 255u) == 0u) { if (xb_ld(&(bar)[XB_TMO])) break; if (_sp > XB_SPIN_CAP) { atomicAdd(&(bar)[XB_TMO], 1u); break; } } } } while (0)

struct XcdBarrier {
    unsigned* bar; unsigned x;
    volatile LAS unsigned* st;
};

__device__ __forceinline__ XcdBarrier xcd_barrier_post(unsigned* bar, volatile LAS unsigned* st) {
    XcdBarrier b; b.bar = bar; b.x = xb_xcc_id(); b.st = st;
    if (my_tid() == 0) (void)xb_add(&bar[XB_XCNT(b.x)], 1u);
    return b;
}
__device__ __forceinline__ void xcd_barrier_complete(unsigned* bar, unsigned x, unsigned& nloc, unsigned& nx) {
    const unsigned G = gridDim.x * gridDim.y * gridDim.z;
    unsigned sum, cnt, mine, sp = 0u;
    for (;;) {
        sum = 0u; cnt = 0u; mine = 0u;
#pragma unroll
        for (unsigned j = 0; j < 16; ++j) { const unsigned c = xb_ld(&bar[XB_XCNT(j)]); sum += c; cnt += (c > 0u) ? 1u : 0u; mine = (j == x) ? c : mine; }
        if (sum == G) break;
        __builtin_amdgcn_s_sleep(1);
        if ((++sp & 255u) == 0u) { if (xb_ld(&bar[XB_TMO])) break; if (sp > XB_SPIN_CAP) { atomicAdd(&bar[XB_TMO], 1u); break; } }
    }
    nloc = mine > 0u ? mine : 1u; nx = cnt > 0u ? cnt : 1u;
}

__device__ __noinline__ void xcd_barrier_impl(unsigned* bar, unsigned bx, volatile LAS unsigned* bst, bool leader);
__device__ __forceinline__ void xcd_barrier(const XcdBarrier& b) { int t_ = my_tid(); asm volatile("" : "+v"(t_)); xcd_barrier_impl(b.bar, b.x, b.st, t_ == 0); }
__device__ __noinline__ void xcd_barrier_impl(unsigned* bar_, unsigned bx_, volatile LAS unsigned* bst_, bool leader) {
    XcdBarrier b; b.bar = bar_; b.x = bx_; b.st = bst_;
    asm volatile("s_waitcnt vmcnt(0)" ::: "memory");
    __syncthreads();
    if (leader) {
        unsigned* bar = b.bar;
        __builtin_amdgcn_s_waitcnt(0);
        unsigned nloc = b.st[0], nx = b.st[1];
        if (nloc == 0u) { xcd_barrier_complete(bar, b.x, nloc, nx); b.st[0] = nloc; b.st[1] = nx; }
        const unsigned old = xb_add(&bar[XB_XSUB(b.x)], 1u);
        const unsigned gen = old / nloc;
        if (old + 1u == (gen + 1u) * nloc) {
            __builtin_amdgcn_fence(__ATOMIC_RELEASE, "agent");
            asm volatile("s_waitcnt vmcnt(0)" ::: "memory");
            const unsigned og = xb_add(&bar[XB_TOP], 1u);
            const unsigned tg = og / nx;
            if (og + 1u == (tg + 1u) * nx) xb_add(&bar[XB_TOPGEN], 1u);
            else XB_SPIN(xb_ld(&bar[XB_TOPGEN]) == tg, bar);
            __builtin_amdgcn_fence(__ATOMIC_ACQUIRE, "agent");
            xb_add(&bar[XB_XGEN(b.x)], 1u);
            asm volatile("s_waitcnt vmcnt(0)" ::: "memory");
        } else {
            XB_SPIN(xb_ld(&bar[XB_XGEN(b.x)]) == gen, bar);
            __builtin_amdgcn_fence(__ATOMIC_ACQUIRE, "agent");
            asm volatile("s_waitcnt vmcnt(0)" ::: "memory");
        }
    }
    __syncthreads();
}

struct Ctx { int tid, lane, wave, gw, ngw; size_t gt, ngt; unsigned char* lds; };

__device__ __forceinline__ void ph_rope_table(const Ctx& c, float* __restrict__ tab) {
    for (size_t ii = c.gt; ii < (size_t)LP * 32; ii += c.ngt) {
        const int i = (int)ii, p = i >> 5, f = i & 31;
        const double inv = exp2(-(double)f * (13.287712379549449 / 32.0));
        const double ang = (double)(p - NMETA) * inv;
        const double rev = ang * 0.15915494309189535;
        const double fr = rev - rint(rev);
        const float a = (float)(fr * 6.283185307179586);
        tab[2 * i] = cosf(a); tab[2 * i + 1] = sinf(a);
    }
}
__device__ __forceinline__ size_t cf_off(size_t i) { const size_t rw = i >> 5; const unsigned cc = (unsigned)(i & 31), key = (unsigned)(rw & 63); return (rw >> 6) * 16384 + (size_t)(((((cc >> 1) * 2 + (key >> 5)) * 2 + (cc & 1)) * 32 + (key & 31)) * 8); }
__device__ __forceinline__ void ph_cache_prep(const Ctx& cx, const Params& P, int part) {
    bf16_t* CALL = (bf16_t*)(P.ws + WS_CALL); bf16_t* KR = (bf16_t*)(P.ws + WS_KR); bf16_t* CF = (bf16_t*)(P.ws + WS_CF);
    const float* clat = P.in[2]; const float* ckr = P.in[3]; const float* mlat = P.in[4]; const float* mkr = P.in[5];
    const size_t gsz = cx.ngt, g0 = cx.gt;
    if (part == 1) {
        constexpr size_t NL = (size_t)DB * PAST * KVL / 8, NR = (size_t)DB * PAST * ROPE / 8;
        constexpr int QL_ = 11, QR_ = 3;
        f32x4 ra[QR_], rb_[QR_];
#pragma unroll
        for (int q = 0; q < QR_; ++q) if (g0 + q * gsz < NR) { ra[q] = *(const f32x4*)(ckr + (g0 + q * gsz) * 8); rb_[q] = *(const f32x4*)(ckr + (g0 + q * gsz) * 8 + 4); }
        { f32x4 a[QL_], b[QL_];
#pragma unroll
          for (int q = 0; q < QL_; ++q) if (g0 + q * gsz < NL) { a[q] = *(const f32x4*)(clat + (g0 + q * gsz) * 8); b[q] = *(const f32x4*)(clat + (g0 + q * gsz) * 8 + 4); }
#pragma unroll
          for (int q = 0; q < QL_; ++q) if (g0 + q * gsz < NL) { const u32x4_t w = pack8(a[q], b[q]); const size_t ii = g0 + q * gsz; *(u32x4_t*)(CALL + (size_t)KV_SC0 * KVL + ii * 8) = w; *(u32x4_t*)(CF + cf_off(ii)) = w; } }
        for (size_t i = g0 + QL_ * gsz; i < NL; i += gsz) { const f32x4 a = *(const f32x4*)(clat + i * 8), b = *(const f32x4*)(clat + i * 8 + 4); const u32x4_t w = pack8(a, b); *(u32x4_t*)(CALL + (size_t)KV_SC0 * KVL + i * 8) = w; *(u32x4_t*)(CF + cf_off(i)) = w; }
#define KR_STORE(ii_, a_, b_) do { const size_t rw = (ii_) >> 3; const int c16 = (int)((ii_) & 7), key = (int)(rw & 63); const size_t tl = rw >> 6; \
            *(u32x4_t*)(KR + (size_t)KV_SC0 * ROPE + tl * 4096 + ((((c16 >> 1) * 2 + (key >> 5)) * 2 + (c16 & 1)) * 32 + (key & 31)) * 8) = pack8(a_, b_); } while (0)
#pragma unroll
        for (int q = 0; q < QR_; ++q) if (g0 + q * gsz < NR) KR_STORE(g0 + q * gsz, ra[q], rb_[q]);
        for (size_t ir = g0 + QR_ * gsz; ir < NR; ir += gsz) { const f32x4 a = *(const f32x4*)(ckr + ir * 8), b = *(const f32x4*)(ckr + ir * 8 + 4); KR_STORE(ir, a, b); }
#undef KR_STORE
    }
    if (part == 1) return;
    for (size_t i = g0; i < (size_t)KVT * KVL / 8; i += gsz) {
        const int tr = (int)(i >> 5), c = (int)(i & 31) * 8, slot = tr >> 6, j = tr & 63; u32x4_t w = {0u, 0u, 0u, 0u}; bool st = false;
        if (slot < NB) st = j >= NMETA;
        else if (j >= 48) st = true;
        else if (j >= 32) { const float* s = mlat + ((size_t)(slot - NB) * NMETA + (j - 32)) * KVL + c; w = pack8(*(const f32x4*)s, *(const f32x4*)(s + 4)); st = true; }
        if (st) *(u32x4_t*)(CALL + (size_t)(KV_T0 + tr) * KVL + c) = w;
    }
    for (size_t i = g0; i < (size_t)KVT * ROPE / 8; i += gsz) {
        const int tr = (int)(i >> 3), c = (int)(i & 7) * 8, slot = tr >> 6, j = tr & 63; u32x4_t w = {0u, 0u, 0u, 0u}; bool st = false;
        if (slot < NB) st = j >= NMETA;
        else if (j >= 48) st = true;
        else if (j >= 32) { const float* s = mkr + ((size_t)(slot - NB) * NMETA + (j - 32)) * ROPE + c; w = pack8(*(const f32x4*)s, *(const f32x4*)(s + 4)); st = true; }
        if (st) *(u32x4_t*)(KR + (size_t)(KV_T0 + tr) * ROPE + c) = w;
    }
}
__device__ __forceinline__ const float* x_row(const Params& P, int r) {
    if (r < TM) return P.in[0] + (size_t)r * D;
    if (r < TMETA0) return P.in[1] + (size_t)(r - TS0) * D;
    return P.in[8] + (size_t)((r - TMETA0) & (NMETA - 1)) * D;
}
__device__ __forceinline__ void ph_xn(const Ctx& c, const Params& P) {
    bf16_t* XN = (bf16_t*)(P.ws + WS_E);
    const int l = c.lane & 15, grp = c.lane >> 4;
    for (int r = c.gw * 4 + grp; r < T; r += c.ngw * 4) {
        const float* x = x_row(P, r);
        f32x4 v[16]; float ss = 0.f;
#pragma unroll
        for (int j = 0; j < 16; ++j) { v[j] = *(const f32x4*)(x + j * 64 + l * 4); ss += (v[j][0] * v[j][0] + v[j][1] * v[j][1]) + (v[j][2] * v[j][2] + v[j][3] * v[j][3]); }
        ss += __shfl_xor(ss, 1); ss += __shfl_xor(ss, 2); ss += __shfl_xor(ss, 4); ss += __shfl_xor(ss, 8);
        const float rs = rsqrtf(ss * (1.f / D) + EPS);
#pragma unroll
        for (int j = 0; j < 16; ++j) { const f32x4 y = v[j] * rs * *(const f32x4*)(P.in[9] + j * 64 + l * 4);
            typedef unsigned u32x2_t __attribute__((ext_vector_type(2))); u32x2_t w; w.x = pg8::cvt_pk_bf16(y[0], y[1]); w.y = pg8::cvt_pk_bf16(y[2], y[3]);
            *(u32x2_t*)(XN + (size_t)r * D + j * 64 + l * 4) = w; }
    }
}
struct EpiG1 {
    static constexpr bool DUAL = false, ROWSSQ = false;
    bf16_t *zq, *U, *GA, *GB;
    __device__ int brow(int j) const { return j; } __device__ int brow2(int j) const { return j; }
    __device__ void operator()(int r, int n, float acc, float) const {
        if (n < O_SSM) zq[(size_t)r * O_SSM + n] = f2bf(acc);
        else if (n < O_GA) { const int ch = n - O_SSM, g = ch >> 4, c = ch & 15; size_t idx;
            if (r < TM) { const int b = r >> 12, t = r & (SEQ - 1); idx = ((size_t)(b * NG + g) * LP + NMETA + t) * GS + c; }
            else if (r < TMETA0) { const int s = r - TS0, b = s >> 5, t = s & 31; idx = (size_t)NB * NG * LP * GS + ((size_t)(b * NG + g) * DS + t) * GS + c; }
            else { const int s = r - TMETA0, b = s >> 4, mm = s & 15; idx = ((size_t)(b * NG + g) * LP + mm) * GS + c; }
            U[idx] = f2bf(acc); }
        else if (n < O_GB) GA[(size_t)r * D + (n - O_GA)] = f2bf(sigmoidf_(acc));
        else if (n < INC) GB[(size_t)r * D + (n - O_GB)] = f2bf(sigmoidf_(acc));
    }
    __device__ void rowstat(int, int, float) const {}
};
struct EpiQ {
    static constexpr bool DUAL = false, ROWSSQ = false;
    bf16_t *Qm, *Qt;
    __device__ int brow(int j) const { return j; } __device__ int brow2(int j) const { return j; }
    __device__ void operator()(int r, int n, float acc, float) const { if (r < TM) Qm[(size_t)r * (NH * QKD) + n] = f2bf(acc); else Qt[(size_t)(r - TM) * (NH * QKD) + n] = f2bf(acc); }
    __device__ void rowstat(int, int, float) const {}
};
typedef unsigned u32x2v __attribute__((ext_vector_type(2)));
__device__ __forceinline__ u32x2v pack4(const f32x4 a) { u32x2v w; w.x = pg8::cvt_pk_bf16(a[0], a[1]); w.y = pg8::cvt_pk_bf16(a[2], a[3]); return w; }
__device__ __forceinline__ f32x4 unpack4(const u32x2v w) { f32x4 a; a[0] = __uint_as_float(w.x << 16); a[1] = __uint_as_float(w.x & 0xffff0000u); a[2] = __uint_as_float(w.y << 16); a[3] = __uint_as_float(w.y & 0xffff0000u); return a; }
struct EpiKV {
    static constexpr bool DUAL = false, ROWSSQ = false;
    bf16_t *Kd, *Vd;
    __device__ int brow(int j) const { return j; } __device__ int brow2(int j) const { return j; }
    __device__ void operator()(int r, int n, float acc, float) const { const int h = n >> 8, d = n & 255; if (d < NOPE) Kd[(size_t)r * D + h * NOPE + d] = f2bf(acc); else Vd[(size_t)r * D + h * VD + (d - NOPE)] = f2bf(acc); }
    struct Pre {}; __device__ Pre pre(int, int) const { return Pre{}; }
    __device__ float vec4(int r, int n, const f32x4 v, const f32x4, const Pre&) const { const int h = n >> 8, d = n & 255; bf16_t* p = d < NOPE ? Kd + (size_t)r * D + h * NOPE + d : Vd + (size_t)r * D + h * VD + (d - NOPE); *(u32x2v*)p = pack4(v); return 0.f; }
    __device__ void rowstat(int, int, float) const {}
};
struct EpiKss {
    static constexpr bool DUAL = false, ROWSSQ = true;
    float* S;
    __device__ int brow(int j) const { return j; } __device__ int brow2(int j) const { return j; }
    __device__ float operator()(int, int, float acc, float) const { return acc * acc; }
    struct Pre {}; __device__ Pre pre(int, int) const { return Pre{}; }
    __device__ float vec4(int, int, const f32x4 v, const f32x4, const Pre&) const { return (v[0] * v[0] + v[1] * v[1]) + (v[2] * v[2] + v[3] * v[3]); }
    __device__ void rowstat(int r, int tn, float s) const { S[(size_t)r * 16 + tn] = s; }
};
struct EpiGlu {
    static constexpr bool DUAL = true, ROWSSQ = false;
    bf16_t* GB;
    __device__ int brow(int j) const { return (j >> 7) * 256 + (j & 127); } __device__ int brow2(int j) const { return (j >> 7) * 256 + 128 + (j & 127); }
    __device__ void operator()(int r, int j, float v, float g) const { bf16_t* p = GB + (size_t)r * D + j; *p = f2bf(bf2f(*p) * v * sigmoidf_(g)); }
    struct Pre { u32x2v gb; }; __device__ Pre pre(int r, int j) const { return Pre{*(const u32x2v*)(GB + (size_t)r * D + j)}; }
    __device__ float vec4(int r, int j, const f32x4 v, const f32x4 g, const Pre& p) const { *(u32x2v*)(GB + (size_t)r * D + j) = pack4(unpack4(p.gb) * v * sig4(g)); return 0.f; }
    __device__ void rowstat(int, int, float) const {}
};
struct EpiMerge {
    static constexpr bool DUAL = false, ROWSSQ = false;
    bf16_t* GA; const bf16_t* OB; int roff;
    __device__ int brow(int j) const { return j; } __device__ int brow2(int j) const { return j; }
    __device__ void operator()(int r, int j, float acc, float) const { bf16_t* p = GA + (size_t)(roff + r) * D + j; *p = f2bf(bf2f(*p) * acc + bf2f(OB[(size_t)(roff + r) * D + j])); }
    struct Pre { u32x2v ga, ob; }; __device__ Pre pre(int r, int j) const { return Pre{*(const u32x2v*)(GA + (size_t)(roff + r) * D + j), *(const u32x2v*)(OB + (size_t)(roff + r) * D + j)}; }
    __device__ float vec4(int r, int j, const f32x4 v, const f32x4, const Pre& p) const { *(u32x2v*)(GA + (size_t)(roff + r) * D + j) = pack4(unpack4(p.ga) * v + unpack4(p.ob)); return 0.f; }
    __device__ void rowstat(int, int, float) const {}
};
struct EpiWp {
    static constexpr bool DUAL = false, ROWSSQ = false;
    bf16_t* Wp;
    __device__ int brow(int j) const { return j; } __device__ int brow2(int j) const { return j; }
    __device__ void operator()(int r, int j, float acc, float) const { Wp[(size_t)r * 2048 + j] = f2bf(acc); }
    __device__ void rowstat(int, int, float) const {}
};
struct EpiH1 {
    static constexpr bool DUAL = false, ROWSSQ = true;
    const float* xs; bf16_t* H1b; float* P2t;
    __device__ int brow(int j) const { return j; } __device__ int brow2(int j) const { return j; }
    __device__ float operator()(int r, int j, float acc, float) const { const float h = xs[(size_t)(r - TS0) * D + j] + acc; H1b[(size_t)r * D + j] = f2bf(h); return h * h; }
    struct Pre {}; __device__ Pre pre(int, int) const { return Pre{}; }
    __device__ float vec4(int r, int j, const f32x4 v, const f32x4, const Pre&) const { const f32x4 h = *(const f32x4*)(xs + (size_t)(r - TS0) * D + j) + v; *(u32x2v*)(H1b + (size_t)r * D + j) = pack4(h); return (h[0] * h[0] + h[1] * h[1]) + (h[2] * h[2] + h[3] * h[3]); }
    __device__ void rowstat(int r, int tn, float s) const { P2t[(size_t)(r - TS0) * 16 + tn] = s; }
};
struct EpiUp {
    static constexpr bool DUAL = false, ROWSSQ = false;
    bf16_t* A1t; const float* P2t;
    __device__ int brow(int j) const { return j; } __device__ int brow2(int j) const { return j; }
    __device__ float operator()(int r, int j, float acc, float) const {
        const f32x4* p = (const f32x4*)(P2t + (size_t)(r - TS0) * 16); const f32x4 a = p[0], b = p[1], c = p[2], d = p[3];
        const float ss = ((a[0] + a[1]) + (a[2] + a[3])) + ((b[0] + b[1]) + (b[2] + b[3])) + ((c[0] + c[1]) + (c[2] + c[3])) + ((d[0] + d[1]) + (d[2] + d[3]));
        const float rs2 = 1.f / (ss * (1.f / D) + EPS), t = fmaxf(acc, 0.f); A1t[(size_t)(r - TM) * DFF + j] = f2bf(t * t * rs2); return 0.f; }
    struct Pre {}; __device__ Pre pre(int, int) const { return Pre{}; }
    __device__ float vec4(int r, int j, const f32x4 v, const f32x4, const Pre&) const {
        const f32x4* p = (const f32x4*)(P2t + (size_t)(r - TS0) * 16); const f32x4 a = p[0], b = p[1], c = p[2], d = p[3];
        const float ss = ((a[0] + a[1]) + (a[2] + a[3])) + ((b[0] + b[1]) + (b[2] + b[3])) + ((c[0] + c[1]) + (c[2] + c[3])) + ((d[0] + d[1]) + (d[2] + d[3]));
        const float rs2 = 1.f / (ss * (1.f / D) + EPS); f32x4 t; t[0] = fmaxf(v[0], 0.f); t[1] = fmaxf(v[1], 0.f); t[2] = fmaxf(v[2], 0.f); t[3] = fmaxf(v[3], 0.f);
        *(u32x2v*)(A1t + (size_t)(r - TM) * DFF + j) = pack4(t * t * rs2); return 0.f; }
    __device__ void rowstat(int, int, float) const {}
};
struct EpiDown {
    static constexpr bool DUAL = false, ROWSSQ = false;
    const bf16_t* H1b; float* O;
    __device__ int brow(int j) const { return j; } __device__ int brow2(int j) const { return j; }
    __device__ float operator()(int r, int j, float acc, float) const { O[(size_t)r * D + j] = bf2f(H1b[(size_t)(TS0 + r) * D + j]) + acc; return 0.f; }
    struct Pre { u32x2v h; }; __device__ Pre pre(int r, int j) const { return Pre{*(const u32x2v*)(H1b + (size_t)(TS0 + r) * D + j)}; }
    __device__ float vec4(int r, int j, const f32x4 v, const f32x4, const Pre& p) const { *(f32x4*)(O + (size_t)r * D + j) = unpack4(p.h) + v; return 0.f; }
    __device__ void rowstat(int, int, float) const {}
};

constexpr int TLD = 68;
template <class Epi, int MF = 4, int NB_ = 3>
__device__ __forceinline__ void ph_gemm_tail(unsigned char* lds_, const bf16_t* __restrict__ A, int lda, const bf16_t* __restrict__ Bt, int ldb, int M0, int M, int N, int K, Epi E, int bid = -1, int nb = 0) {
    if (bid < 0) { bid = blockIdx.x; nb = gridDim.x; }
    int tid_ = my_tid(); asm volatile("" : "+v"(tid_));
    const int tid = tid_, w = __builtin_amdgcn_readfirstlane(tid >> 6), lane = tid & 63, fr = lane & 15, fq = lane >> 4;
    typedef __attribute__((address_space(3))) float lds_f;
    lds_f* PL = (lds_f*)lds_;
    constexpr int NCOL = Epi::DUAL ? 32 : 64;
    const int ntm = (M - M0) / (16 * MF), ntn = N / NCOL, ntiles = ntm * ntn, nks = K >> 5;
    for (int tile = bid; tile < ntiles; tile += nb) {
        const int tm = tile % ntm, tn = tile / ntm, r0 = M0 + tm * (16 * MF), j0 = tn * NCOL;
        f32x4 acc[MF][4];
#pragma unroll
        for (int a = 0; a < MF; ++a)
#pragma unroll
            for (int b = 0; b < 4; ++b) acc[a][b] = (f32x4){0.f, 0.f, 0.f, 0.f};
        const bf16_t* Ar = A + (size_t)r0 * lda;
        unsigned ao[MF], bo[4];
#pragma unroll
        for (int mf = 0; mf < MF; ++mf) ao[mf] = (unsigned)((16 * mf + fr) * lda + 8 * fq);
#pragma unroll
        for (int nf = 0; nf < 4; ++nf) { const int jj = 16 * nf + fr; const int br = Epi::DUAL ? (jj < 32 ? E.brow(j0 + jj) : E.brow2(j0 + jj - 32)) : E.brow(j0 + jj); bo[nf] = (unsigned)(br * ldb + 8 * fq); }
        constexpr int NQ_ = Epi::DUAL ? 1 : MF / 2;
        typename Epi::Pre pre[NQ_];
        if (Epi::DUAL) { if (tid < 128 * MF) pre[0] = E.pre(r0 + (tid >> 3), j0 + (tid & 7) * 4); }
        else {
#pragma unroll
            for (int i = 0; i < NQ_; ++i) { const int o = tid + NTHR * i; pre[i] = E.pre(r0 + (o >> 4), j0 + (o & 15) * 4); } }
        for (int ks0 = w; ks0 < nks; ks0 += NB_ * NWV) {
            bf16x8 af[NB_][MF], bf[NB_][4];
#pragma unroll
            for (int q = 0; q < NB_; ++q) { const int ks = ks0 + q * NWV;
                if (ks < nks) {
#pragma unroll
                    for (int mf = 0; mf < MF; ++mf) af[q][mf] = *(const bf16x8*)(Ar + ao[mf] + 32 * ks);
#pragma unroll
                    for (int nf = 0; nf < 4; ++nf) bf[q][nf] = *(const bf16x8*)(Bt + bo[nf] + 32 * ks);
                } }
#pragma unroll
            for (int q = 0; q < NB_; ++q) { const int ks = ks0 + q * NWV;
                if (ks < nks) {
#pragma unroll
                    for (int mf = 0; mf < MF; ++mf)
#pragma unroll
                        for (int nf = 0; nf < 4; ++nf) acc[mf][nf] = __builtin_amdgcn_mfma_f32_16x16x32_bf16(bf[q][nf], af[q][mf], acc[mf][nf], 0, 0, 0);
                } }
        }
        __syncthreads();
#pragma unroll
        for (int mf = 0; mf < MF; ++mf)
#pragma unroll
            for (int nf = 0; nf < 4; ++nf) *(__attribute__((address_space(3))) f32x4*)(PL + (size_t)w * 64 * TLD + (16 * mf + fr) * TLD + 16 * nf + 4 * fq) = acc[mf][nf];
        __syncthreads();
        typedef __attribute__((address_space(3))) f32x4 lds_f4;
        if (Epi::DUAL) {
            if (tid < 128 * MF) { const int row = tid >> 3, cq = (tid & 7) * 4; f32x4 v = {0.f, 0.f, 0.f, 0.f}, g = {0.f, 0.f, 0.f, 0.f};
#pragma unroll
                for (int ww = 0; ww < NWV; ++ww) { v += *(const lds_f4*)(PL + ww * 64 * TLD + row * TLD + cq); g += *(const lds_f4*)(PL + ww * 64 * TLD + row * TLD + 32 + cq); }
                E.vec4(r0 + row, j0 + cq, v, g, pre[0]); }
        } else {
#pragma unroll
            for (int i = 0; i < MF / 2; ++i) { const int o = tid + NTHR * i, row = o >> 4, cq = (o & 15) * 4; f32x4 v = {0.f, 0.f, 0.f, 0.f};
#pragma unroll
                for (int ww = 0; ww < NWV; ++ww) v += *(const lds_f4*)(PL + ww * 64 * TLD + row * TLD + cq);
                if constexpr (Epi::ROWSSQ) { float s = E.vec4(r0 + row, j0 + cq, v, v, pre[i]); s += __shfl_xor(s, 1); s += __shfl_xor(s, 2); s += __shfl_xor(s, 4); s += __shfl_xor(s, 8); if ((lane & 15) == 0) E.rowstat(r0 + row, tn, s); }
                else E.vec4(r0 + row, j0 + cq, v, v, pre[i]); }
        }
    }
    __syncthreads();
}
#define PG8_EPI_ROWS(...) _Pragma("unroll") for (int ai = 0; ai < 2; ++ai) _Pragma("unroll") for (int m = 0; m < 4; ++m) { const int row = u.pm * 256 + ai * 128 + wr * 64 + m * 16 + fr; __VA_ARGS__ asm volatile("" ::: "memory"); }

struct PEpUp {
    static constexpr bool PERM = true, AFTER_DRAIN = false;
    bf16_t* O; const float* P2;
    __device__ __forceinline__ void operator()(const f32x4 (&acc)[2][2][4][2], const pg8::Unit& u, int wr, int wc, int fr, int fq) const {
        f32x4 pv[2][4];
#pragma unroll
        for (int ai = 0; ai < 2; ++ai)
#pragma unroll
            for (int m = 0; m < 4; ++m) pv[ai][m] = *(const f32x4*)(P2 + (size_t)(u.pm * 256 + ai * 128 + wr * 64 + m * 16 + fr) * 4);
#pragma unroll
        for (int ai = 0; ai < 2; ++ai)
#pragma unroll
            for (int m = 0; m < 4; ++m) { const int row = u.pm * 256 + ai * 128 + wr * 64 + m * 16 + fr; const f32x4 p = pv[ai][m];
                const float rs2 = __builtin_amdgcn_rcpf(((p[0] + p[1]) + (p[2] + p[3])) * (1.f / D) + EPS);
#pragma unroll
                for (int bj = 0; bj < 2; ++bj) { const int c0 = u.pn * 256 + bj * 128 + wc * 32 + 8 * fq;
                    f32x4 a = acc[ai][bj][m][0], b = acc[ai][bj][m][1];
#pragma unroll
                    for (int i = 0; i < 4; ++i) { const float x = fmaxf(a[i], 0.f), y = fmaxf(b[i], 0.f); a[i] = x * x * rs2; b[i] = y * y * rs2; }
                    *(u32x4_t*)(O + (size_t)row * DFF + c0) = pack8(a, b); }
                asm volatile("" ::: "memory"); }
    }
};
struct PEpH1 {
    static constexpr bool PERM = true, AFTER_DRAIN = false;
    const float* x; bf16_t* H1b; float* P2; PG8_LAS float* X;
    __device__ __forceinline__ void operator()(const f32x4 (&acc)[2][2][4][2], const pg8::Unit& u, int wr, int wc, int fr, int fq) const {
        float ss[2][4];
#pragma unroll
        for (int ai = 0; ai < 2; ++ai)
#pragma unroll
            for (int m = 0; m < 4; ++m) ss[ai][m] = 0.f;
#pragma unroll
        for (int bj = 0; bj < 2; ++bj) {
            const size_t o0 = (size_t)(u.pm * 256 + wr * 64 + fr) * D + u.pn * 256 + bj * 128 + wc * 32 + 8 * fq;
            f32x4 xv[2][4][2];
#pragma unroll
            for (int ai = 0; ai < 2; ++ai)
#pragma unroll
                for (int m = 0; m < 4; ++m) { const float* p = x + o0 + (size_t)(ai * 128 + m * 16) * D; xv[ai][m][0] = *(const f32x4*)p; xv[ai][m][1] = *(const f32x4*)(p + 4); }
#pragma unroll
            for (int ai = 0; ai < 2; ++ai)
#pragma unroll
                for (int m = 0; m < 4; ++m) { const f32x4 a = xv[ai][m][0] + acc[ai][bj][m][0], b = xv[ai][m][1] + acc[ai][bj][m][1];
                    ss[ai][m] += (a[0] * a[0] + a[1] * a[1]) + (a[2] * a[2] + a[3] * a[3]) + (b[0] * b[0] + b[1] * b[1]) + (b[2] * b[2] + b[3] * b[3]);
                    *(u32x4_t*)(H1b + o0 + (size_t)(ai * 128 + m * 16) * D) = pack8(a, b); }
            asm volatile("" ::: "memory");
        }
#pragma unroll
        for (int ai = 0; ai < 2; ++ai)
#pragma unroll
            for (int m = 0; m < 4; ++m) { float s = ss[ai][m]; s = rowsum4(s); if (fq == 0) X[(ai * 128 + wr * 64 + m * 16 + fr) * 4 + wc] = s; }
        asm volatile("s_waitcnt lgkmcnt(0)" ::: "memory"); __builtin_amdgcn_s_barrier(); asm volatile("" ::: "memory");
        if (wc == 0 && fq == 0) {
#pragma unroll
            for (int ai = 0; ai < 2; ++ai)
#pragma unroll
                for (int m = 0; m < 4; ++m) { const int rl = ai * 128 + wr * 64 + m * 16 + fr; const f32x4 p = *(const PG8_LAS f32x4*)(X + rl * 4);
                    P2[(size_t)(u.pm * 256 + rl) * 4 + u.pn] = (p[0] + p[1]) + (p[2] + p[3]); }
        }
        asm volatile("s_waitcnt lgkmcnt(0)" ::: "memory"); __builtin_amdgcn_s_barrier(); asm volatile("" ::: "memory");
    }
};
struct PEpDown {
    static constexpr bool PERM = false, AFTER_DRAIN = false;
    const bf16_t* H1b; float* out;
    __device__ __forceinline__ void operator()(const f32x4 (&acc)[2][2][4][2], const pg8::Unit& u, int wr, int wc, int fr, int fq) const {
        typedef unsigned u32x2_t __attribute__((ext_vector_type(2)));
#pragma unroll
        for (int bj = 0; bj < 2; ++bj) {
            const size_t o0 = (size_t)(u.pm * 256 + wr * 64 + fr) * D + u.pn * 256 + bj * 128 + wc * 32 + 4 * fq;
            u32x2_t hv[2][4][2];
#pragma unroll
            for (int ai = 0; ai < 2; ++ai)
#pragma unroll
                for (int m = 0; m < 4; ++m)
#pragma unroll
                    for (int n = 0; n < 2; ++n) hv[ai][m][n] = *(const u32x2_t*)(H1b + o0 + (size_t)(ai * 128 + m * 16) * D + 16 * n);
#pragma unroll
            for (int ai = 0; ai < 2; ++ai)
#pragma unroll
                for (int m = 0; m < 4; ++m)
#pragma unroll
                    for (int n = 0; n < 2; ++n) { const u32x2_t h = hv[ai][m][n]; f32x4 r;
                        r[0] = __uint_as_float(h.x << 16); r[1] = __uint_as_float(h.x & 0xffff0000u); r[2] = __uint_as_float(h.y << 16); r[3] = __uint_as_float(h.y & 0xffff0000u);
                        *(f32x4*)(out + o0 + (size_t)(ai * 128 + m * 16) * D + 16 * n) = r + acc[ai][bj][m][n]; }
            asm volatile("" ::: "memory");
        }
    }
};
struct PEpG1 {
    static constexpr bool PERM = true, AFTER_DRAIN = false;
    bf16_t *zq, *U, *GA, *GB;
    __device__ __forceinline__ void operator()(const f32x4 (&acc)[2][2][4][2], const pg8::Unit& u, int wr, int wc, int fr, int fq) const {
        PG8_EPI_ROWS(
            if (row < T) {
            _Pragma("unroll") for (int bj = 0; bj < 2; ++bj) { const int cb = u.pn * 256 + bj * 128 + wc * 32, c0 = cb + 8 * fq;
                const f32x4 a = acc[ai][bj][m][0], b = acc[ai][bj][m][1];
                if (cb < O_SSM) *(u32x4_t*)(zq + (size_t)row * O_SSM + c0) = pack8(a, b);
                else if (cb < O_GA) { const int ch = c0 - O_SSM, g = ch >> 4, cc = ch & 15; size_t idx;
                    if (row < TM) { const int bb = row >> 12, t = row & (SEQ - 1); idx = ((size_t)(bb * NG + g) * LP + NMETA + t) * GS + cc; }
                    else if (row < TMETA0) { const int s_ = row - TS0, bb = s_ >> 5, t = s_ & 31; idx = (size_t)NB * NG * LP * GS + ((size_t)(bb * NG + g) * DS + t) * GS + cc; }
                    else { const int s_ = row - TMETA0, bb = s_ >> 4, mm = s_ & 15; idx = ((size_t)(bb * NG + g) * LP + mm) * GS + cc; }
                    *(u32x4_t*)(U + idx) = pack8(a, b); }
                else if (cb < O_GB) *(u32x4_t*)(GA + (size_t)row * D + (c0 - O_GA)) = pack8(sig4(a), sig4(b));
                else if (cb < INC) *(u32x4_t*)(GB + (size_t)row * D + (c0 - O_GB)) = pack8(sig4(a), sig4(b)); } } )
    }
};
struct PEpStore {
    static constexpr bool PERM = true, AFTER_DRAIN = false;
    bf16_t *Qm, *Qt; int ldc;
    __device__ __forceinline__ void operator()(const f32x4 (&acc)[2][2][4][2], const pg8::Unit& u, int wr, int wc, int fr, int fq) const {
        PG8_EPI_ROWS(
            if (row < T) { bf16_t* o = row < TM ? Qm + (size_t)row * ldc : Qt + (size_t)(row - TM) * ldc;
            _Pragma("unroll") for (int bj = 0; bj < 2; ++bj) { const int c0 = u.pn * 256 + bj * 128 + wc * 32 + 8 * fq;
                *(u32x4_t*)(o + c0) = pack8(acc[ai][bj][m][0], acc[ai][bj][m][1]); } } )
    }
};
struct PEpKV {
    static constexpr bool PERM = true, AFTER_DRAIN = false;
    bf16_t *Kd, *Vd;
    __device__ __forceinline__ void operator()(const f32x4 (&acc)[2][2][4][2], const pg8::Unit& u, int wr, int wc, int fr, int fq) const {
        PG8_EPI_ROWS(
            const size_t o = (size_t)row * D + u.pn * 128 + wc * 32 + 8 * fq;
            *(u32x4_t*)(Kd + o) = pack8(acc[ai][0][m][0], acc[ai][0][m][1]);
            *(u32x4_t*)(Vd + o) = pack8(acc[ai][1][m][0], acc[ai][1][m][1]); )
    }
};
template <int FRAGK> struct PEpKVn {
    static constexpr bool PERM = true, AFTER_DRAIN = false;
    bf16_t *Kd, *Vd; const float* gk; PG8_LAS float* X;
    __device__ __forceinline__ void operator()(const f32x4 (&acc)[2][2][4][2], const pg8::Unit& u, int wr, int wc, int fr, int fq) const {
        const unsigned vbase = (unsigned)((u.pm * 256 + wr * 64 + fr) * D + u.pn * 128 + wc * 32 + 8 * fq);
        const int c16 = wc * 4 + fq;
        const unsigned kfb = (unsigned)((u.pn * (DB * PAST / 64) + u.pm * 4 + wr) * 8192 + ((c16 >> 1) * 4 + (c16 & 1)) * 256 + fr * 8);
#pragma unroll
        for (int ai = 0; ai < 2; ++ai)
#pragma unroll
            for (int m = 0; m < 4; ++m) { const int rl = ai * 128 + wr * 64 + m * 16 + fr; const f32x4 a = acc[ai][0][m][0], b = acc[ai][0][m][1];
                float s = (a[0] * a[0] + a[1] * a[1]) + (a[2] * a[2] + a[3] * a[3]) + (b[0] * b[0] + b[1] * b[1]) + (b[2] * b[2] + b[3] * b[3]);
                s = rowsum4(s);
                if (fq == 0) X[rl * 4 + wc] = s;
                if (!FRAGK) *(u32x4_t*)(Vd + vbase + (unsigned)((ai * 128 + m * 16) * D)) = pack8(acc[ai][1][m][0], acc[ai][1][m][1]); }
        asm volatile("s_waitcnt lgkmcnt(0)" ::: "memory"); __builtin_amdgcn_s_barrier(); asm volatile("" ::: "memory");
        const f32x4 g0 = *(const f32x4*)(gk + wc * 32 + 8 * fq), g1 = *(const f32x4*)(gk + wc * 32 + 8 * fq + 4);
#pragma unroll
        for (int ai = 0; ai < 2; ++ai)
#pragma unroll
            for (int m = 0; m < 4; ++m) { const int rl = ai * 128 + wr * 64 + m * 16 + fr; const f32x4 p = *(const PG8_LAS f32x4*)(X + rl * 4);
                const float rs = rsqrtf(((p[0] + p[1]) + (p[2] + p[3])) * (1.f / NOPE) + EPS);
                const unsigned ko = FRAGK ? kfb + (unsigned)(ai * 2 * 8192 + (m >> 1) * 512 + (m & 1) * 128) : vbase + (unsigned)((ai * 128 + m * 16) * D);
                *(u32x4_t*)(Kd + ko) = pack8(acc[ai][0][m][0] * rs * g0, acc[ai][0][m][1] * rs * g1); }
        asm volatile("s_waitcnt lgkmcnt(0)" ::: "memory"); __builtin_amdgcn_s_barrier(); asm volatile("" ::: "memory");
    }
};
struct PEpKrms {
    static constexpr bool PERM = true, AFTER_DRAIN = false;
    float* IK; PG8_LAS float* X;
    __device__ __forceinline__ void operator()(const f32x4 (&acc)[2][2][4][2], const pg8::Unit& u, int wr, int wc, int fr, int fq) const {
#pragma unroll
        for (int bj = 0; bj < 2; ++bj)
#pragma unroll
            for (int ai = 0; ai < 2; ++ai)
#pragma unroll
                for (int m = 0; m < 4; ++m) { const int rl = ai * 128 + wr * 64 + m * 16 + fr; const f32x4 a = acc[ai][bj][m][0], b = acc[ai][bj][m][1];
                    float s = (a[0] * a[0] + a[1] * a[1]) + (a[2] * a[2] + a[3] * a[3]) + (b[0] * b[0] + b[1] * b[1]) + (b[2] * b[2] + b[3] * b[3]);
                    s = rowsum4(s);
                    if (fq == 0) X[(bj * 256 + rl) * 4 + wc] = s; }
        asm volatile("s_waitcnt lgkmcnt(0)" ::: "memory"); __builtin_amdgcn_s_barrier(); asm volatile("" ::: "memory");
        { const int t = (wr * 4 + wc) * 64 + fq * 16 + fr, bj = t >> 8, rl = t & 255; const f32x4 p = *(const PG8_LAS f32x4*)(X + (bj * 256 + rl) * 4);
          IK[(size_t)(u.pn * 2 + bj) * (DB * PAST) + u.pm * 256 + rl] = rsqrtf(((p[0] + p[1]) + (p[2] + p[3])) * (1.f / NOPE) + EPS); }
        asm volatile("s_waitcnt lgkmcnt(0)" ::: "memory"); __builtin_amdgcn_s_barrier(); asm volatile("" ::: "memory");
    }
};
struct PEpGlu {
    static constexpr bool PERM = true, AFTER_DRAIN = false;
    bf16_t* GB;
    __device__ __forceinline__ void operator()(const f32x4 (&acc)[2][2][4][2], const pg8::Unit& u, int wr, int wc, int fr, int fq) const {
        bf16_t* base = GB + (size_t)(u.pm * 256 + wr * 64 + fr) * D + u.pn * 128 + wc * 32 + 8 * fq;
        u32x4_t gv[2][4];
#pragma unroll
        for (int ai = 0; ai < 2; ++ai)
#pragma unroll
            for (int m = 0; m < 4; ++m) gv[ai][m] = *(const u32x4_t*)(base + (size_t)(ai * 128 + m * 16) * D);
#pragma unroll
        for (int ai = 0; ai < 2; ++ai)
#pragma unroll
            for (int m = 0; m < 4; ++m) { f32x4 ga; f32x4 gb; unpack8(gv[ai][m], ga, gb);
                const f32x4 o0 = ga * acc[ai][0][m][0] * sig4(acc[ai][1][m][0]); const f32x4 o1 = gb * acc[ai][0][m][1] * sig4(acc[ai][1][m][1]);
                *(u32x4_t*)(base + (size_t)(ai * 128 + m * 16) * D) = pack8(o0, o1); }
    }
};
struct PEpMerge {
    static constexpr bool PERM = true, AFTER_DRAIN = false;
    bf16_t* GA; const bf16_t* OB;
    __device__ __forceinline__ void operator()(const f32x4 (&acc)[2][2][4][2], const pg8::Unit& u, int wr, int wc, int fr, int fq) const {
#pragma unroll
        for (int bj = 0; bj < 2; ++bj) {
            const size_t o0 = (size_t)(u.pm * 256 + wr * 64 + fr) * D + u.pn * 256 + bj * 128 + wc * 32 + 8 * fq;
            u32x4_t gv[2][4], ov[2][4];
#pragma unroll
            for (int ai = 0; ai < 2; ++ai)
#pragma unroll
                for (int m = 0; m < 4; ++m) { gv[ai][m] = *(const u32x4_t*)(GA + o0 + (size_t)(ai * 128 + m * 16) * D); ov[ai][m] = *(const u32x4_t*)(OB + o0 + (size_t)(ai * 128 + m * 16) * D); }
#pragma unroll
            for (int ai = 0; ai < 2; ++ai)
#pragma unroll
                for (int m = 0; m < 4; ++m) { f32x4 ga; f32x4 gb; f32x4 oa; f32x4 ob; unpack8(gv[ai][m], ga, gb); unpack8(ov[ai][m], oa, ob);
                    *(u32x4_t*)(GA + o0 + (size_t)(ai * 128 + m * 16) * D) = pack8(ga * acc[ai][bj][m][0] + oa, gb * acc[ai][bj][m][1] + ob); }
            asm volatile("" ::: "memory");
        }
    }
};
struct PEpResF32 {
    static constexpr bool PERM = false, AFTER_DRAIN = false;
    const float* base; float* out;
    __device__ __forceinline__ void operator()(const f32x4 (&acc)[2][2][4][2], const pg8::Unit& u, int wr, int wc, int fr, int fq) const {
#pragma unroll
        for (int bj = 0; bj < 2; ++bj) {
            const size_t o0 = (size_t)(u.pm * 256 + wr * 64 + fr) * D + u.pn * 256 + bj * 128 + wc * 32 + 4 * fq;
            f32x4 bv[2][4][2];
#pragma unroll
            for (int ai = 0; ai < 2; ++ai)
#pragma unroll
                for (int m = 0; m < 4; ++m)
#pragma unroll
                    for (int n = 0; n < 2; ++n) bv[ai][m][n] = *(const f32x4*)(base + o0 + (size_t)(ai * 128 + m * 16) * D + 16 * n);
#pragma unroll
            for (int ai = 0; ai < 2; ++ai)
#pragma unroll
                for (int m = 0; m < 4; ++m)
#pragma unroll
                    for (int n = 0; n < 2; ++n) *(f32x4*)(out + o0 + (size_t)(ai * 128 + m * 16) * D + 16 * n) = bv[ai][m][n] + acc[ai][bj][m][n];
            asm volatile("" ::: "memory");
        }
    }
};
struct WJob { const float* src; bf16_t* dst; int K, N, mode, item0; const float* kscale; };
__device__ __forceinline__ void wt_item(const WJob& J, int item, __attribute__((address_space(3))) float* scr, int lane) {
    const int nblk = J.N >> 5, kb = item / nblk, nb = item % nblk, k0 = 64 * kb, n0 = 32 * nb;
    if (J.mode == 3 && (n0 & 128)) return;
    float vv[32];
#pragma unroll
    for (int i = 0; i < 32; ++i) vv[i] = J.src[(size_t)(k0 + 2 * i + (lane >> 5)) * J.N + n0 + (lane & 31)];
    const float* ks = J.kscale ? J.kscale + k0 + (lane >> 5) : nullptr;
#pragma unroll
    for (int i = 0; i < 32; ++i) scr[(2 * i + (lane >> 5)) * 33 + (lane & 31)] = ks ? vv[i] * ks[2 * i] : vv[i];
    asm volatile("s_waitcnt lgkmcnt(0)" ::: "memory");
    const int c = lane & 7;
    const int rb = J.mode == 0 ? n0 : (J.mode == 3 ? ((n0 >> 8) * 128 + (n0 & 127)) : ((n0 >> 7) * 256 + (n0 & 127) + (J.mode == 2 ? 128 : 0)));
#pragma unroll
    for (int j = 0; j < 4; ++j) { const int n = (lane >> 3) + 8 * j; const __attribute__((address_space(3))) float* s = scr + (8 * c) * 33 + n;
        u32x4_t o; o.x = pg8::cvt_pk_bf16(s[0 * 33], s[1 * 33]); o.y = pg8::cvt_pk_bf16(s[2 * 33], s[3 * 33]); o.z = pg8::cvt_pk_bf16(s[4 * 33], s[5 * 33]); o.w = pg8::cvt_pk_bf16(s[6 * 33], s[7 * 33]);
        *(u32x4_t*)(J.dst + (size_t)(rb + n) * J.K + k0 + 8 * c) = o; }
    asm volatile("s_waitcnt lgkmcnt(0)" ::: "memory");
}
__device__ __forceinline__ void ph_weights(const Params& P, unsigned char* lds, int mask, int gb, int ngb) {
    unsigned char* ws = P.ws;
    int tid_ = my_tid(); asm volatile("" : "+v"(tid_));
    const int lane = tid_ & 63, wave = tid_ >> 6, gw = gb * NWV + wave, ngw = ngb * NWV;
    __attribute__((address_space(3))) float* scr = (__attribute__((address_space(3))) float*)((__attribute__((address_space(3))) unsigned char*)lds + wave * 16384);
    const WJob jobs[10] = {
        {P.in[10], (bf16_t*)(ws + WS_WIN), D, INC, 0, 0, nullptr}, {P.in[12], (bf16_t*)(ws + WS_WUQ), QL, NH * QKD, 0, 0, nullptr}, {P.in[17], (bf16_t*)(ws + WS_WUKV), KVL, 2048, 0, 0, nullptr},
        {P.in[17], (bf16_t*)(ws + WS_WUKK), KVL, 2048, 3, 0, nullptr},
        {P.in[28], (bf16_t*)(ws + WS_WGLU), D, D, 1, 0, nullptr}, {P.in[29], (bf16_t*)(ws + WS_WGLU), D, D, 2, 0, nullptr},
        {P.in[19], (bf16_t*)(ws + WS_WO), D, D, 0, 0, nullptr}, {P.in[30], (bf16_t*)(ws + WS_WOUT), D, D, 0, 0, nullptr},
        {P.in[32], (bf16_t*)(ws + WS_WUP), D, DFF, 0, 0, P.in[31]},
        {P.in[33], (bf16_t*)(ws + WS_WDN), DFF, D, 0, 0, nullptr}};
    int base = 0;
#pragma unroll
    for (int j = 0; j < 10; ++j) {
        if (!((mask >> j) & 1)) continue;
        const int n = (jobs[j].K >> 6) * (jobs[j].N >> 5);
        int first = gw - (base % ngw); if (first < 0) first += ngw;
        for (int it = first; it < n; it += ngw) wt_item(jobs[j], it, scr, lane);
        base += n;
    }
    if (mask & 1) {
        bf16_t* WB = (bf16_t*)(ws + WS_WUKVB); const float* wsrc = P.in[17];
        for (int i = gw * 64 + lane; i < KVL * 2048 / 8; i += ngw * 64) { f32x4 a = *(const f32x4*)(wsrc + (size_t)i * 8), b = *(const f32x4*)(wsrc + (size_t)i * 8 + 4); const int d = (i * 8) & 255;
            if (d < NOPE) { a *= *(const f32x4*)(P.in[13] + d) * *(const f32x4*)(P.in[18] + d); b *= *(const f32x4*)(P.in[13] + d + 4) * *(const f32x4*)(P.in[18] + d + 4); }
            *(u32x4_t*)(WB + (size_t)i * 8) = pack8(a, b); }
        if (gw == 0) { float* gkq = (float*)(ws + WS_GKQ); gkq[lane] = P.in[13][lane] * P.in[18][lane]; gkq[lane + 64] = P.in[13][lane + 64] * P.in[18][lane + 64]; }
    }
    if (mask & 1) {
        bf16_t* Win = (bf16_t*)(ws + WS_WIN);
        for (int i = gw * 64 + lane; i < (INCP - INC) * D / 8; i += ngw * 64) *(u32x4_t*)(Win + (size_t)INC * D + (size_t)i * 8) = (u32x4_t){0u, 0u, 0u, 0u};
    }
}
namespace ssm {
typedef __attribute__((address_space(3))) float lds_f;
struct cd { double re, im; };
__device__ __forceinline__ cd cmul(cd a, cd b) { return cd{a.re * b.re - a.im * b.im, a.re * b.im + a.im * b.re}; }
__device__ __forceinline__ void dsincos(double x, double& s, double& c) {
    const double q = rint(x * 0.6366197723675814); const double t = (x - q * 1.5707963267948966) - q * 6.123233995736766e-17; const double t2 = t * t;
    double sp = -7.647163731819816e-13; sp = sp * t2 + 1.605904383682161e-10; sp = sp * t2 - 2.505210838544172e-08; sp = sp * t2 + 2.755731922398589e-06; sp = sp * t2 - 1.984126984126984e-04;
    sp = sp * t2 + 8.333333333333333e-03; sp = sp * t2 - 1.666666666666667e-01; const double st = t + t * t2 * sp;
    double cp = 4.779477332387385e-14; cp = cp * t2 - 1.147074559772972e-11; cp = cp * t2 + 2.08767569878681e-09; cp = cp * t2 - 2.755731922398589e-07; cp = cp * t2 + 2.48015873015873e-05;
    cp = cp * t2 - 1.388888888888889e-03; cp = cp * t2 + 4.166666666666666e-02; cp = cp * t2 - 0.5; const double ct = 1.0 + t2 * cp;
    const int qi = ((int)q) & 3;
    s = (qi == 0) ? st : (qi == 1) ? ct : (qi == 2) ? -st : -ct;
    c = (qi == 0) ? ct : (qi == 1) ? -st : (qi == 2) ? -ct : st;
}
__device__ __forceinline__ double shfl_d(double v, int src) { const unsigned long long u = __builtin_bit_cast(unsigned long long, v);
    const unsigned lo = __shfl((unsigned)u, src), hi = __shfl((unsigned)(u >> 32), src); return __builtin_bit_cast(double, ((unsigned long long)hi << 32) | lo); }
__device__ __forceinline__ void ph_tables(const Ctx& cx, const Params& P) {
    const int n = cx.lane;
    bf16_t* KT = (bf16_t*)(P.ws + WS_KTAB); bf16_t* QT = (bf16_t*)(P.ws + WS_QTAB); bf16_t* PT = (bf16_t*)(P.ws + WS_PTAB); float* L16 = (float*)(P.ws + WS_L16);
    typedef __attribute__((address_space(3))) float lf;
    typedef float f2_t __attribute__((ext_vector_type(2)));
    lf* SC = (lf*)((__attribute__((address_space(3))) unsigned char*)cx.lds + cx.wave * 16384);
    __attribute__((address_space(3))) f2_t* GL = (__attribute__((address_space(3))) f2_t*)((__attribute__((address_space(3))) unsigned char*)cx.lds + 131072 + cx.wave * 512);
    for (int it = cx.gw; it < NG * 32; it += cx.ngw) {
        const int g = it >> 5, sub = it & 31, idx = sub & 15;
        const float are_f = P.in[20][g * NS + n], aim_f = P.in[21][g * NS + n], ldt_f = P.in[22][g];
        f32x4 st[4][4];
#pragma unroll
        for (int i = 0; i < 4; ++i) { st[0][i] = *(const f32x4*)(P.in[25] + (size_t)g * 1024 + (i * 64 + n) * 4); st[1][i] = *(const f32x4*)(P.in[26] + (size_t)g * 1024 + (i * 64 + n) * 4);
                                      st[2][i] = *(const f32x4*)(P.in[23] + (size_t)g * 1024 + (i * 64 + n) * 4); st[3][i] = *(const f32x4*)(P.in[24] + (size_t)g * 1024 + (i * 64 + n) * 4); }
        const double are = are_f, aim = aim_f, dt = exp((double)ldt_f);
        double sn, cs; dsincos(aim * dt, sn, cs); const double mag = exp(are * dt);
        const cd lam{mag * cs, mag * sn}; const double den = are * are + aim * aim;
        const cd f{((lam.re - 1.0) * are + lam.im * aim) / den, (lam.im * are - (lam.re - 1.0) * aim) / den};
#pragma unroll
        for (int i = 0; i < 4; ++i) {
#pragma unroll
            for (int e = 0; e < 4; ++e) { const int q = (i * 64 + n) * 4 + e;
                SC[(q & 63) * 16 + (q >> 6)] = st[0][i][e]; SC[1024 + (q & 63) * 16 + (q >> 6)] = st[1][i][e]; }
            *(__attribute__((address_space(3))) f32x4*)(SC + 2048 + (i * 64 + n) * 4) = st[2][i]; *(__attribute__((address_space(3))) f32x4*)(SC + 3072 + (i * 64 + n) * 4) = st[3][i]; }
      for (int kind = sub < 16 ? 0 : 1; kind < (sub < 16 ? 1 : 3); ++kind) {
        const int npow = kind == 0 ? idx : (kind == 1 ? idx + 1 : 15 - idx);
        cd pw{1.0, 0.0};
        for (int k = 0; k < npow; ++k) pw = cmul(pw, lam);
        if (kind == 0) {
            const cd gn = cmul(pw, f); const int c = n >> 2, c0 = (n & 3) * 4;
            float acc[4] = {0.f, 0.f, 0.f, 0.f};
            GL[n] = (f2_t){(float)gn.re, (float)gn.im};
            asm volatile("s_waitcnt lgkmcnt(0)" ::: "memory");
#pragma unroll 8
            for (int m = 0; m < NS; ++m) {
                const f2_t gv = GL[m]; const float cr = SC[m * 16 + c], ci = SC[1024 + m * 16 + c];
                const float zr = cr * gv[0] - ci * gv[1], zi = cr * gv[1] + ci * gv[0];
                const f32x4 br = *(const __attribute__((address_space(3))) f32x4*)(SC + 2048 + m * 16 + c0), bi = *(const __attribute__((address_space(3))) f32x4*)(SC + 3072 + m * 16 + c0);
#pragma unroll
                for (int e = 0; e < 4; ++e) acc[e] += zr * br[e] - zi * bi[e];
            }
#pragma unroll
            for (int e = 0; e < 4; ++e) { float v = acc[e]; if (idx == 0 && c0 + e == c) v += P.in[27][g * GS + c]; KT[((size_t)(g * 16 + idx) * GS + c) * GS + c0 + e] = f2bf(v); }
        } else if (kind == 1) {
            asm volatile("s_waitcnt lgkmcnt(0)" ::: "memory");
            const float pr = (float)pw.re, pi = (float)pw.im;
#pragma unroll 4
            for (int c = 0; c < GS; ++c) { const float cr = SC[n * 16 + c], ci = SC[1024 + n * 16 + c];
                bf16_t* q = QT + ((size_t)g * 256 + idx * GS + c) * 128; q[n] = f2bf(cr * pr - ci * pi); q[NS + n] = f2bf(-(cr * pi + ci * pr)); }
            if (idx == 15) { L16[(size_t)(g * NS + n) * 2] = (float)pw.re; L16[(size_t)(g * NS + n) * 2 + 1] = (float)pw.im; }
        } else {
            const cd gn = cmul(pw, f); const float gr = (float)gn.re, gi = (float)gn.im;
#pragma unroll 4
            for (int c = 0; c < GS; ++c) { const float br = SC[2048 + n * 16 + c], bi = SC[3072 + n * 16 + c];
                PT[((size_t)g * 128 + n) * 256 + idx * GS + c] = f2bf(gr * br - gi * bi); PT[((size_t)g * 128 + NS + n) * 256 + idx * GS + c] = f2bf(gr * bi + gi * br); }
        }
      }
      asm volatile("s_waitcnt lgkmcnt(0)" ::: "memory");
    }
}
constexpr int SLD = 132;
__device__ __forceinline__ float gelu_fast(float x) { const float u = 0.7978845608028654f * (x + 0.044715f * x * x * x); return x * __builtin_amdgcn_rcpf(1.f + __expf(-2.f * u)); }
constexpr int PJ = 6, ULD = 264;
constexpr int SSM_S_BYTES = PJ * 16 * SLD * 4, SSM_LDS = SSM_S_BYTES + PJ * 16 * ULD * 2;
__device__ __forceinline__ void run_unit(const Params& P, unsigned char* lds_, bool prm, int b, int g) {
    int tid_ = my_tid(); asm volatile("" : "+v"(tid_));
    const int tid = tid_, w = __builtin_amdgcn_readfirstlane(tid >> 6), lane = tid & 63, fr = lane & 15, fq = lane >> 4;
    lds_f* S = (lds_f*)lds_;
    __attribute__((address_space(3))) bf16_t* UL = (__attribute__((address_space(3))) bf16_t*)((__attribute__((address_space(3))) unsigned char*)lds_ + SSM_S_BYTES);
    const bf16_t* KT = (const bf16_t*)(P.ws + WS_KTAB) + (size_t)g * 16 * 256; const bf16_t* QT = (const bf16_t*)(P.ws + WS_QTAB) + (size_t)g * 256 * 128;
    const bf16_t* PT = (const bf16_t*)(P.ws + WS_PTAB) + (size_t)g * 128 * 256; const float* L16 = (const float*)(P.ws + WS_L16) + (size_t)g * NS * 2;
    const bf16_t* Ub = (const bf16_t*)(P.ws + WS_U) + (prm ? (size_t)(b * NG + g) * LP * GS : (size_t)NB * NG * LP * GS + (size_t)g * DS * GS);
    const unsigned strF = prm ? 256u : (unsigned)(NG * DS * GS), strJ = prm ? 4096u : 256u;
    const int njb = prm ? 17 : 2;
    bf16_t* SA = (bf16_t*)(P.ws + WS_E);
    const int srow = tid >> 5, spc = tid & 31;
    const bf16_t* ug = Ub + (size_t)srow * strF + spc * 8;
    bf16x8 upf[PJ];
#pragma unroll
    for (int i = 0; i < PJ; ++i) if (i < njb) upf[i] = *(const bf16x8*)(ug + (size_t)i * strJ);
    bf16x8 pf[8], ku0[4], ku1[8], qh0[4], qh1[4];
    const int t0 = w, t1 = 15 - w;
#pragma unroll
    for (int ks = 0; ks < 8; ++ks) { pf[ks] = *(const bf16x8*)(PT + (size_t)(16 * w + fr) * 256 + 32 * ks + 8 * fq);
        const int s = 2 * ks + (fq >> 1), c0 = 8 * (fq & 1);
        if (ks < 4) ku0[ks & 3] = (t0 - s >= 0) ? *(const bf16x8*)(KT + ((size_t)(t0 - s) * GS + fr) * GS + c0) : bf16x8{};
        ku1[ks] = (t1 - s >= 0) ? *(const bf16x8*)(KT + ((size_t)(t1 - s) * GS + fr) * GS + c0) : bf16x8{}; }
#pragma unroll
    for (int ks = 0; ks < 4; ++ks) { qh0[ks] = *(const bf16x8*)(QT + (size_t)(t0 * GS + fr) * 128 + 32 * ks + 8 * fq); qh1[ks] = *(const bf16x8*)(QT + (size_t)(t1 * GS + fr) * 128 + 32 * ks + 8 * fq); }
    float lr = 0.f, li = 0.f, hr = 0.f, hi = 0.f;
    if (prm) { lr = L16[2 * lane]; li = L16[2 * lane + 1]; }
    for (int jb0 = 0; jb0 < njb; jb0 += PJ) {
        const int nj = (njb - jb0) < PJ ? (njb - jb0) : PJ;
        __syncthreads();
#pragma unroll
        for (int i = 0; i < PJ; ++i) if (i < nj) *(__attribute__((address_space(3))) bf16x8*)(UL + (size_t)(16 * i + srow) * ULD + spc * 8) = upf[i];
#pragma unroll
        for (int i = 0; i < PJ; ++i) if (jb0 + PJ + i < njb) upf[i] = *(const bf16x8*)(ug + (size_t)(jb0 + PJ + i) * strJ);
        __syncthreads();
        for (int i = 0; i < nj; ++i) {
            bf16x8 uf[8];
#pragma unroll
            for (int ks = 0; ks < 8; ++ks) uf[ks] = *(const __attribute__((address_space(3))) bf16x8*)(UL + (size_t)(16 * i + fr) * ULD + 32 * ks + 8 * fq);
            asm volatile("s_waitcnt lgkmcnt(0)" ::: "memory"); __builtin_amdgcn_sched_barrier(0);
            f32x4 acc = {0.f, 0.f, 0.f, 0.f}, acd = {0.f, 0.f, 0.f, 0.f};
#pragma unroll
            for (int ks = 0; ks < 8; ks += 2) { acc = __builtin_amdgcn_mfma_f32_16x16x32_bf16(pf[ks], uf[ks], acc, 0, 0, 0); acd = __builtin_amdgcn_mfma_f32_16x16x32_bf16(pf[ks + 1], uf[ks + 1], acd, 0, 0, 0); }
            *(__attribute__((address_space(3))) f32x4*)(S + (16 * i + fr) * SLD + 16 * w + 4 * fq) = acc + acd;
        }
        __syncthreads();
        if (prm) {
            lds_f* TX = (lds_f*)((__attribute__((address_space(3))) unsigned char*)lds_ + SSM_LDS);
            if (w < nj) {
                const int j0 = 16 * w; float sr[16], si[16];
#pragma unroll
                for (int e2 = 0; e2 < 16; ++e2) { sr[e2] = S[(j0 + e2) * SLD + lane]; si[e2] = S[(j0 + e2) * SLD + NS + lane]; }
                float cr = 0.f, ci = 0.f, mr = 1.f, mi = 0.f;
#pragma unroll
                for (int e2 = 0; e2 < 16; ++e2) { if (16 * jb0 + j0 + e2 < 257) { S[(j0 + e2) * SLD + lane] = cr; S[(j0 + e2) * SLD + NS + lane] = ci;
                    const float nr = lr * cr - li * ci + sr[e2], ni = lr * ci + li * cr + si[e2]; cr = nr; ci = ni;
                    const float m2 = lr * mr - li * mi, m3 = lr * mi + li * mr; mr = m2; mi = m3; } }
                TX[(w * 4 + 0) * 64 + lane] = cr; TX[(w * 4 + 1) * 64 + lane] = ci; TX[(w * 4 + 2) * 64 + lane] = mr; TX[(w * 4 + 3) * 64 + lane] = mi;
            }
            __syncthreads();
            float hwr = hr, hwi = hi;
            for (int k = 0; k < nj; ++k) { if (k == w) { hwr = hr; hwi = hi; }
                const float tr = TX[(k * 4 + 0) * 64 + lane], ti = TX[(k * 4 + 1) * 64 + lane], mr = TX[(k * 4 + 2) * 64 + lane], mi = TX[(k * 4 + 3) * 64 + lane];
                const float nr = mr * hr - mi * hi + tr, ni = mr * hi + mi * hr + ti; hr = nr; hi = ni; }
            if (w < nj) {
                const int j0 = 16 * w; float qr_ = hwr, qi_ = hwi, pr_[16], pi_[16];
#pragma unroll
                for (int e2 = 0; e2 < 16; ++e2) { pr_[e2] = S[(j0 + e2) * SLD + lane]; pi_[e2] = S[(j0 + e2) * SLD + NS + lane]; }
#pragma unroll
                for (int e2 = 0; e2 < 16; ++e2) { if (16 * jb0 + j0 + e2 < 257) { S[(j0 + e2) * SLD + lane] = pr_[e2] + qr_; S[(j0 + e2) * SLD + NS + lane] = pi_[e2] + qi_;
                    const float nr = lr * qr_ - li * qi_, ni = lr * qi_ + li * qr_; qr_ = nr; qi_ = ni; } }
            }
            if (w == 0 && jb0 + PJ >= njb) { P.out[OO_SREP + (size_t)(b * NG + g) * NS + lane] = hr; P.out[OO_SIMP + (size_t)(b * NG + g) * NS + lane] = hi; }
        } else {
#pragma unroll
            for (int i = 0; i < 2; ++i) { const int ch = tid + NTHR * i, bb = ch >> 6, n = ch & 63;
                const float l0 = L16[2 * n], l1 = L16[2 * n + 1]; float h0 = P.in[6][(size_t)(bb * NG + g) * NS + n], h1 = P.in[7][(size_t)(bb * NG + g) * NS + n];
#pragma unroll
                for (int j = 0; j < 2; ++j) { const int row = 16 * j + bb; const float sr = S[row * SLD + n], si = S[row * SLD + NS + n]; S[row * SLD + n] = h0; S[row * SLD + NS + n] = h1;
                    const float nr = l0 * h0 - l1 * h1 + sr, ni = l0 * h1 + l1 * h0 + si; h0 = nr; h1 = ni; }
                P.out[OO_SRES + (size_t)(bb * NG + g) * NS + n] = h0; P.out[OO_SIMS + (size_t)(bb * NG + g) * NS + n] = h1; }
        }
        __syncthreads();
        for (int i = 0; i < nj; ++i) {
            bf16x8 uf[8], hf[4];
#pragma unroll
            for (int ks = 0; ks < 8; ++ks) uf[ks] = *(const __attribute__((address_space(3))) bf16x8*)(UL + (size_t)(16 * i + fr) * ULD + 32 * ks + 8 * fq);
            f32x4 hx[4][2];
#pragma unroll
            for (int ks = 0; ks < 4; ++ks) { const lds_f* hp = S + (16 * i + fr) * SLD + 32 * ks + 8 * fq; hx[ks][0] = *(const __attribute__((address_space(3))) f32x4*)hp; hx[ks][1] = *(const __attribute__((address_space(3))) f32x4*)(hp + 4); }
            asm volatile("s_waitcnt lgkmcnt(0)" ::: "memory"); __builtin_amdgcn_sched_barrier(0);
#pragma unroll
            for (int ks = 0; ks < 4; ++ks) { u32x4_t hw; hw.x = pg8::cvt_pk_bf16(hx[ks][0][0], hx[ks][0][1]); hw.y = pg8::cvt_pk_bf16(hx[ks][0][2], hx[ks][0][3]); hw.z = pg8::cvt_pk_bf16(hx[ks][1][0], hx[ks][1][1]); hw.w = pg8::cvt_pk_bf16(hx[ks][1][2], hx[ks][1][3]);
                hf[ks] = __builtin_bit_cast(bf16x8, hw); }
            f32x4 a0 = {0.f, 0.f, 0.f, 0.f}, a1 = {0.f, 0.f, 0.f, 0.f};
#pragma unroll
            for (int ks = 0; ks < 4; ++ks) { a0 = __builtin_amdgcn_mfma_f32_16x16x32_bf16(qh0[ks], hf[ks], a0, 0, 0, 0); a1 = __builtin_amdgcn_mfma_f32_16x16x32_bf16(qh1[ks], hf[ks], a1, 0, 0, 0); }
#pragma unroll
            for (int ks = 0; ks < 8; ++ks) {
                if (ks < 4 && 2 * ks <= t0) a0 = __builtin_amdgcn_mfma_f32_16x16x32_bf16(ku0[ks & 3], uf[ks], a0, 0, 0, 0);
                if (2 * ks <= t1) a1 = __builtin_amdgcn_mfma_f32_16x16x32_bf16(ku1[ks], uf[ks], a1, 0, 0, 0); }
            const int row = 16 * (jb0 + i) + fr;
            if (prm ? row < 257 : true) {
#pragma unroll
                for (int e2 = 0; e2 < 2; ++e2) { const int t = e2 ? t1 : t0; const f32x4 a = e2 ? a1 : a0; size_t orow;
                    if (prm) { const int l = 16 * row + t; orow = l < NMETA ? (size_t)(TMETA0 + b * NMETA + l) : (size_t)b * SEQ + (l - NMETA); }
                    else orow = (size_t)TS0 + (size_t)fr * DS + 16 * (jb0 + i) + t;
                    typedef unsigned u32x2_t __attribute__((ext_vector_type(2)));
                    u32x2_t o; o.x = pg8::cvt_pk_bf16(gelu_fast(a[0]), gelu_fast(a[1])); o.y = pg8::cvt_pk_bf16(gelu_fast(a[2]), gelu_fast(a[3]));
                    *(u32x2_t*)(SA + orow * D + g * GS + 4 * fq) = o; }
            }
        }
    }
}
__device__ __forceinline__ void ph_ssm(const Params& P, unsigned char* lds) {
    for (int u = blockIdx.x; u < NB * NG + NG; u += gridDim.x) {
        if (u < NB * NG) run_unit(P, lds, true, u >> 6, u & 63); else run_unit(P, lds, false, 0, u - NB * NG);
    }
}
}

__device__ __forceinline__ float grp16_sum(float v) { v += __shfl_xor(v, 1); v += __shfl_xor(v, 2); v += __shfl_xor(v, 4); v += __shfl_xor(v, 8); return v; }
__device__ __forceinline__ void ph_norm1(const Ctx& cx, const Params& P) {
    const int l = cx.lane & 15, grp = cx.lane >> 4;
    typedef unsigned u32x2_t __attribute__((ext_vector_type(2)));
    constexpr int NR_ = 3;
    for (int rb = cx.gw * 4 + grp; rb < T; rb += NR_ * cx.ngw * 4) {
      u32x4_t qv_[NR_][3], kvv_[NR_][2]; u32x2_t krv_[NR_];
#pragma unroll
      for (int it = 0; it < NR_; ++it) { const int r = rb + it * cx.ngw * 4;
        if (r < T) { const bf16_t* z = (const bf16_t*)(P.ws + WS_ZQ) + (size_t)r * O_SSM;
#pragma unroll
            for (int i = 0; i < 3; ++i) qv_[it][i] = *(const u32x4_t*)(z + 8 * l + 128 * i);
#pragma unroll
            for (int i = 0; i < 2; ++i) kvv_[it][i] = *(const u32x4_t*)(z + O_KV + 8 * l + 128 * i);
            krv_[it] = *(const u32x2_t*)(z + O_KR + 4 * l); } }
#pragma unroll
      for (int it = 0; it < NR_; ++it) { const int r = rb + it * cx.ngw * 4;
       if (r < T) {
        bf16_t* CQ = (bf16_t*)(P.ws + WS_CQ) + (size_t)r * QL;
        const int kvr = row_kvr(r);
        bf16_t* CA = (bf16_t*)(P.ws + WS_CALL) + (size_t)kvr * KVL; bf16_t* KR = (bf16_t*)(P.ws + WS_KR) + (size_t)kvr * ROPE;
        float *olat, *okr;
        if (r < TM) { olat = P.out + OO_LATP + (size_t)r * KVL; okr = P.out + OO_KRP + (size_t)r * ROPE; }
        else if (r < TMETA0) { olat = P.out + OO_LATS + (size_t)(r - TS0) * KVL; okr = P.out + OO_KRS + (size_t)(r - TS0) * ROPE; }
        else { olat = P.out + OO_MLAT + (size_t)(r - TMETA0) * KVL; okr = P.out + OO_MKR + (size_t)(r - TMETA0) * ROPE; }
        const u32x4_t (&qv)[3] = qv_[it]; const u32x4_t (&kvv)[2] = kvv_[it]; const u32x2_t krv = krv_[it];
        f32x4 qa[3], qb[3], ka[2], kb[2]; float sq = 0.f, sk = 0.f;
#pragma unroll
        for (int i = 0; i < 3; ++i) { unpack8(qv[i], qa[i], qb[i]); sq += (qa[i][0] * qa[i][0] + qa[i][1] * qa[i][1]) + (qa[i][2] * qa[i][2] + qa[i][3] * qa[i][3]) + (qb[i][0] * qb[i][0] + qb[i][1] * qb[i][1]) + (qb[i][2] * qb[i][2] + qb[i][3] * qb[i][3]); }
#pragma unroll
        for (int i = 0; i < 2; ++i) { unpack8(kvv[i], ka[i], kb[i]); sk += (ka[i][0] * ka[i][0] + ka[i][1] * ka[i][1]) + (ka[i][2] * ka[i][2] + ka[i][3] * ka[i][3]) + (kb[i][0] * kb[i][0] + kb[i][1] * kb[i][1]) + (kb[i][2] * kb[i][2] + kb[i][3] * kb[i][3]); }
        f32x4 kr; kr[0] = __uint_as_float(krv.x << 16); kr[1] = __uint_as_float(krv.x & 0xffff0000u); kr[2] = __uint_as_float(krv.y << 16); kr[3] = __uint_as_float(krv.y & 0xffff0000u);
        const float sr = (kr[0] * kr[0] + kr[1] * kr[1]) + (kr[2] * kr[2] + kr[3] * kr[3]);
        const float rq = rsqrtf(grp16_sum(sq) * (1.f / QL) + EPS), rk = rsqrtf(grp16_sum(sk) * (1.f / KVL) + EPS), rr = rsqrtf(grp16_sum(sr) * (1.f / ROPE) + EPS);
#pragma unroll
        for (int i = 0; i < 3; ++i) { const f32x4 g0 = *(const f32x4*)(P.in[11] + 8 * l + 128 * i), g1 = *(const f32x4*)(P.in[11] + 8 * l + 128 * i + 4);
            *(u32x4_t*)(CQ + 8 * l + 128 * i) = pack8(qa[i] * rq * g0, qb[i] * rq * g1); }
#pragma unroll
        for (int i = 0; i < 2; ++i) { const f32x4 g0 = *(const f32x4*)(P.in[15] + 8 * l + 128 * i), g1 = *(const f32x4*)(P.in[15] + 8 * l + 128 * i + 4);
            const f32x4 v0 = ka[i] * rk * g0, v1 = kb[i] * rk * g1;
            *(f32x4*)(olat + 8 * l + 128 * i) = v0; *(f32x4*)(olat + 8 * l + 128 * i + 4) = v1; *(u32x4_t*)(CA + 8 * l + 128 * i) = pack8(v0, v1); }
        const f32x4 y = kr * rr * *(const f32x4*)(P.in[16] + 4 * l);
        f32x4 yo; yo[0] = __shfl_xor(y[0], 8); yo[1] = __shfl_xor(y[1], 8); yo[2] = __shfl_xor(y[2], 8); yo[3] = __shfl_xor(y[3], 8);
        const float* tab = (const float*)(P.ws + WS_ROPE) + ((size_t)(row_pos(r) + NMETA) * 32 + 4 * (l & 7)) * 2;
        const f32x4 t0 = *(const f32x4*)tab, t1 = *(const f32x4*)(tab + 4);
        f32x4 o;
        if (l < 8) { o[0] = y[0] * t0[0] - yo[0] * t0[1]; o[1] = y[1] * t0[2] - yo[1] * t0[3]; o[2] = y[2] * t1[0] - yo[2] * t1[1]; o[3] = y[3] * t1[2] - yo[3] * t1[3]; }
        else       { o[0] = y[0] * t0[0] + yo[0] * t0[1]; o[1] = y[1] * t0[2] + yo[1] * t0[3]; o[2] = y[2] * t1[0] + yo[2] * t1[1]; o[3] = y[3] * t1[2] + yo[3] * t1[3]; }
        *(f32x4*)(okr + 4 * l) = o;
        u32x2_t w; w.x = pg8::cvt_pk_bf16(o[0], o[1]); w.y = pg8::cvt_pk_bf16(o[2], o[3]); *(u32x2_t*)(KR + 4 * l) = w;
       } }
    }
}

struct KvPtrs { const bf16_t *Kp, *Vp, *Ks, *Vs, *Kt, *Vt, *KR; };
__device__ __forceinline__ const bf16_t* kv_row(const bf16_t* p, const bf16_t* s, const bf16_t* t, int kvr) {
    return kvr < KV_SC0 ? p + (size_t)kvr * D : (kvr < KV_T0 ? s + (size_t)(kvr - KV_SC0) * D : t + (size_t)(kvr - KV_T0) * D);
}

__device__ __forceinline__ void ph_weights(const Params& P, unsigned char* lds, int mask, int gb, int ngb);
__device__ __forceinline__ void ph_attn_meta(const Ctx& cx, const Params& P, const KvPtrs& kp) {
    const int lane = cx.lane;
    float* Q = (float*)cx.lds + (size_t)cx.wave * 256;
    __syncthreads();
    for (int w = cx.gw; w < NB * NMETA * NH; w += cx.ngw) {
        const int r = TMETA0 + (w >> 3), h = w & 7, b = (r - TMETA0) >> 4;
        const bf16_t* q = (const bf16_t*)(P.ws + WS_QT) + (size_t)(r - TM) * (NH * QKD) + h * QKD;
        const float a0 = bf2f(q[lane]), a1 = bf2f(q[lane + 64]), bq = bf2f(q[NOPE + lane]);
        const float rn = rsqrtf(wave_sum(a0 * a0 + a1 * a1) * (1.f / NOPE) + EPS), rr = rsqrtf(wave_sum(bq * bq) * (1.f / ROPE) + EPS);
        Q[lane] = a0 * rn * P.in[13][lane] * P.in[18][lane]; Q[lane + 64] = a1 * rn * P.in[13][lane + 64] * P.in[18][lane + 64];
        const float y = bq * rr * P.in[14][lane], yo = __shfl_xor(y, 32);
        const float* tab = (const float*)(P.ws + WS_ROPE) + ((size_t)(row_pos(r) + NMETA) * 32 + (lane & 31)) * 2;
        Q[NOPE + lane] = lane < 32 ? y * tab[0] - yo * tab[1] : y * tab[0] + yo * tab[1];
        __builtin_amdgcn_s_waitcnt(0);
        const int i = lane & 15;
        const int kvr = KV_PM0 + b * 64 + i;
        const bf16_t* k = kp.Kt + (size_t)(kvr - KV_T0) * D + h * NOPE; const bf16_t* kr = kp.KR + (size_t)kvr * ROPE;
        float sn = 0.f, sk = 0.f, sr = 0.f;
        for (int d = 0; d < NOPE; d += 8) { const bf16x8 kvv = *(const bf16x8*)(k + d);
#pragma unroll
            for (int e = 0; e < 8; ++e) { const float kf = bf2f((bf16_t)kvv[e]); sn += Q[d + e] * kf; sk += kf * kf; } }
        for (int d = 0; d < ROPE; d += 8) { const bf16x8 kvv = *(const bf16x8*)(kr + d);
#pragma unroll
            for (int e = 0; e < 8; ++e) sr += Q[NOPE + d + e] * bf2f((bf16_t)kvv[e]); }
        const float s = (sn * rsqrtf(sk * (1.f / NOPE) + EPS) + sr) * ATTN_SCALE;
        float mx = s;
#pragma unroll
        for (int o = 1; o < 16; o <<= 1) mx = fmaxf(mx, __shfl_xor(mx, o));
        const float p = __expf(s - mx); float sum = p;
#pragma unroll
        for (int o = 1; o < 16; o <<= 1) sum += __shfl_xor(sum, o);
        float o0 = 0.f, o1 = 0.f;
#pragma unroll
        for (int j = 0; j < 16; ++j) { const float pj = __shfl(p, j);
            const unsigned vv = *(const unsigned*)(kp.Vt + (size_t)(KV_PM0 - KV_T0 + b * 64 + j) * D + h * VD + 2 * lane);
            o0 += pj * __uint_as_float(vv << 16); o1 += pj * __uint_as_float(vv & 0xffff0000u); }
        const float il = 1.f / sum;
        *(unsigned*)((bf16_t*)(P.ws + WS_E) + (size_t)r * D + h * VD + 2 * lane) = (unsigned)f2bf(o0 * il) | ((unsigned)f2bf(o1 * il) << 16);
        __builtin_amdgcn_s_waitcnt(0);
    }
}
__device__ __forceinline__ void ph_attn_prompt(const Params& P, const KvPtrs& kp, unsigned char* lds_) {
    att::lds_t* lds = (att::lds_t*)lds_;
    const int G = gridDim.x, bx = blockIdx.x, vcu = (G % 8 == 0) ? (bx % 8) * (G / 8) + bx / 8 : bx;
    for (int p = vcu; p < NB * NH * 8; p += G) {
        const int bh = p >> 3, k = p & 7, b = bh >> 3, h = bh & 7;
#pragma unroll 1
        for (int s = 0; s < 2; ++s) {
            const int qb = s == 0 ? 15 - k : k;
            att::Unit U;
            const size_t row0 = (size_t)b * SEQ + (size_t)qb * 256;
            U.Q = (const bf16_t*)(P.ws + WS_QM) + row0 * (NH * QKD) + h * QKD; U.O = (bf16_t*)(P.ws + WS_E) + row0 * D + h * VD;
            U.K0 = kp.Kt + (size_t)(KV_PM0 - KV_T0 + b * 64) * D + h * NOPE; U.V0 = kp.Vt + (size_t)(KV_PM0 - KV_T0 + b * 64) * D + h * VD; U.KR0 = kp.KR + (size_t)(KV_PM0 + b * 64) * ROPE; U.n0 = 1;
            U.K1 = kp.Kp + (size_t)b * SEQ * D + h * NOPE; U.V1 = kp.Vp + (size_t)b * SEQ * D + h * VD; U.KR1 = kp.KR + (size_t)b * SEQ * ROPE; U.n1 = 4 * qb + 4;
            U.jm = 0; U.nv = NMETA; U.nact = NWV; U.lim0 = 4 * qb + 2; U.lstep = 1; U.raw0 = 1; U.raw1 = 0; U.pos0 = qb * 256;
            U.gqn = P.in[13]; U.gqr = P.in[14]; U.gkn = (const float*)(P.ws + WS_GKQ); U.rtab = (const float*)(P.ws + WS_ROPE);
            att::run_unit(U, lds);
        }
    }
}
__device__ __forceinline__ void ph_attn_sample(const Params& P, const KvPtrs& kp, unsigned char* lds_) {
    att::lds_t* lds = (att::lds_t*)lds_;
    const int G = gridDim.x, bx = blockIdx.x, vcu = (G % 8 == 0) ? (bx % 8) * (G / 8) + bx / 8 : bx;
    for (int p = vcu; p < 2 * DB * NH; p += G) {
        const int b = p >> 4, h = (p >> 1) & 7, hf = p & 1;
        att::Unit U;
        U.Q = (const bf16_t*)(P.ws + WS_QT) + (size_t)(b * DS) * (NH * QKD) + h * QKD; U.O = (bf16_t*)(P.ws + WS_OLAT) + (size_t)(b * DS) * 2048 + h * 256;
        U.K0 = (const bf16_t*)(P.ws + WS_CF) + (size_t)b * PAST * KVL; U.IK0 = (const float*)(P.ws + WS_IK) + (size_t)h * (DB * PAST) + (size_t)b * PAST; U.WB = (const bf16_t*)(P.ws + WS_WUKVB) + h * 256; U.cnt = (unsigned*)(P.ws + WS_BAR) + XCD_BAR_WORDS + (p >> 1); U.WV = (const bf16_t*)(P.ws + WS_WUKV) + (size_t)(h * 256 + NOPE) * KVL; U.O2 = (bf16_t*)(P.ws + WS_E) + (size_t)(TS0 + b * DS) * D + h * VD; U.V0 = (const bf16_t*)(P.ws + WS_CALL) + (size_t)(KV_SC0 + b * PAST) * KVL; U.KR0 = kp.KR + (size_t)(KV_SC0 + b * PAST) * ROPE; U.n0 = PAST / 64;
        U.K1 = nullptr; U.IK1 = (const float*)(P.ws + WS_IKT) + (size_t)(b * 64) * 16 + 2 * h; U.V1 = (const bf16_t*)(P.ws + WS_CALL) + (size_t)(KV_ST0 + b * 64) * KVL; U.KR1 = kp.KR + (size_t)(KV_ST0 + b * 64) * ROPE; U.n1 = 1;
        U.jm = PAST / 64; U.nv = 48; U.nact = 1; U.lim0 = PAST / 64 + 1; U.lstep = 0; U.raw0 = 0; U.raw1 = 1; U.pos0 = PAST;
        U.gqn = P.in[13]; U.gqr = P.in[14]; U.gkn = (const float*)(P.ws + WS_GKQ); U.rtab = (const float*)(P.ws + WS_ROPE);
        att::run_sample_unit(U, lds, hf);
    }
}
__device__ __forceinline__ Ctx mk_ctx(unsigned char* lds) {
    int tid = my_tid(); asm volatile("" : "+v"(tid));
    Ctx c; c.tid = tid; c.lane = tid & 63; c.wave = tid >> 6; c.gw = blockIdx.x * NWV + c.wave; c.ngw = gridDim.x * NWV;
    c.gt = (size_t)blockIdx.x * NTHR + tid; c.ngt = (size_t)gridDim.x * NTHR; c.lds = lds; return c;
}
__device__ __forceinline__ unsigned char* opaque_ptr(unsigned char* p) { unsigned lo = (unsigned)(unsigned long long)p, hi = (unsigned)((unsigned long long)p >> 32); asm volatile("" : "+v"(lo), "+v"(hi));
    lo = __builtin_amdgcn_readfirstlane(lo); hi = __builtin_amdgcn_readfirstlane(hi); return (unsigned char*)(((unsigned long long)hi << 32) | lo); }
#define PH_WS unsigned char* ws = opaque_ptr(P.ws);
#define PH_GEMM(EP, A_, B_, M_, N_, K_, ...) { pg8::Gemm g{A_, B_, M_, N_, K_}; pg8::StaticOrder S; S.init(M_, N_, (int)gridDim.x, (int)blockIdx.x); \
      pg8::gemm_phase<EP, pg8::StaticOrder, true, true>((PG8_LAS unsigned char*)lds, g, S, EP{__VA_ARGS__}); }
__device__ __forceinline__ KvPtrs mk_kv(const Params& P, unsigned char* ws) {
    bf16_t* KP = (bf16_t*)(P.out + OO_Y);
    return KvPtrs{KP, KP + (size_t)TM * D, KP, (bf16_t*)(ws + WS_VS), (bf16_t*)(ws + WS_KT), (bf16_t*)(ws + WS_VT), (bf16_t*)(ws + WS_KR)};
}
__global__ void __launch_bounds__(NTHR) mega_fwd(Params P) {
    extern __shared__ __attribute__((aligned(16))) unsigned char lds[];
    cg::grid_group grid = cg::this_grid();
    unsigned* barw = (unsigned*)(P.ws + WS_BAR);
    volatile LAS unsigned* bst = (volatile LAS unsigned*)((LAS unsigned char*)lds + (LDS_BYTES - 16));
    if (threadIdx.x < 2) bst[threadIdx.x] = 0u;
    if ((threadIdx.x & 63) == 0) *(volatile LAS int*)(uintptr_t)(TIDTAB_OFF + hw_slot() * 4) = (int)(threadIdx.x >> 6);
    __syncthreads();
    const XcdBarrier xbar = xcd_barrier_post(barw, bst);
    if (P.ws == nullptr) grid.sync();
    { PH_WS;
      ph_weights(P, lds, 0x7f, (int)blockIdx.x, (int)gridDim.x);
      ph_rope_table(mk_ctx(lds), (float*)(ws + WS_ROPE));
      ph_cache_prep(mk_ctx(lds), P, 0);
      ssm::ph_tables(mk_ctx(lds), P);
      ph_xn(mk_ctx(lds), P); }
    xcd_barrier(xbar);
    { PH_WS; bf16_t *E_ = (bf16_t*)(ws + WS_E), *Win = (bf16_t*)(ws + WS_WIN), *ZQ = (bf16_t*)(ws + WS_ZQ), *U = (bf16_t*)(ws + WS_U), *GA = (bf16_t*)(ws + WS_GA), *GB = (bf16_t*)(ws + WS_GB);
      PH_GEMM(PEpG1, E_, Win, TPAD, INCP, D, ZQ, U, GA, GB) }
    xcd_barrier(xbar);
    { const bool skip = gridDim.x == 256 && blockIdx.x < NG;
      Ctx c = mk_ctx(lds);
      if (gridDim.x == 256) { const int vb = (int)blockIdx.x - NG; c.gw = vb * NWV + c.wave; c.ngw = (256 - NG) * NWV; c.gt = (size_t)vb * NTHR + c.tid; c.ngt = (size_t)(256 - NG) * NTHR; }
      if (!skip) ph_norm1(c, P);
      ssm::ph_ssm(P, lds);
      if (!skip) ph_cache_prep(c, P, 1); }
    xcd_barrier(xbar);
    { PH_WS; bf16_t *CQ = (bf16_t*)(ws + WS_CQ), *Wuq = (bf16_t*)(ws + WS_WUQ), *QM = (bf16_t*)(ws + WS_QM), *QT = (bf16_t*)(ws + WS_QT);
      PH_GEMM(PEpStore, CQ, Wuq, TPAD, NH * QKD, QL, QM, QT, NH * QKD) }
    { PH_WS; bf16_t *CALL = (bf16_t*)(ws + WS_CALL);
      PH_GEMM(PEpKrms, CALL + (size_t)KV_SC0 * KVL, (bf16_t*)(ws + WS_WUKK), DB * PAST, NH * NOPE, KVL, (float*)(ws + WS_IK), (PG8_LAS float*)((PG8_LAS unsigned char*)lds + 131072)) }
    { PH_WS; bf16_t *E_ = (bf16_t*)(ws + WS_E), *Wglu = (bf16_t*)(ws + WS_WGLU), *GB = (bf16_t*)(ws + WS_GB);
      PH_GEMM(PEpGlu, E_, Wglu, TM, 2 * D, D, GB)
      if (gridDim.x == 256) { const int bx = (int)blockIdx.x;
        const int vid = bx >= 146 ? bx - 146 : bx + 110; if (vid < 146) ph_gemm_tail<EpiGlu, 4, 4>(lds, E_, D, Wglu, D, TM, TOUT, D, D, EpiGlu{GB}, vid, 146); }
      else ph_gemm_tail(lds, E_, D, Wglu, D, TM, TOUT, D, D, EpiGlu{GB}); }
    { PH_WS; bf16_t *CALL = (bf16_t*)(ws + WS_CALL), *Wukv = (bf16_t*)(ws + WS_WUKV); const KvPtrs kp = mk_kv(P, ws);
      PH_GEMM(PEpKVn<0>, CALL, Wukv, TM, 2048, KVL, (bf16_t*)kp.Kp, (bf16_t*)kp.Vp, (const float*)(ws + WS_GKQ), (PG8_LAS float*)((PG8_LAS unsigned char*)lds + 131072))
      ph_gemm_tail(lds, CALL + (size_t)KV_PM0 * KVL, KVL, Wukv, KVL, 0, NB * 64, 2048, KVL, EpiKV{(bf16_t*)kp.Kt, (bf16_t*)kp.Vt});
      ph_gemm_tail(lds, CALL + (size_t)KV_ST0 * KVL, KVL, (bf16_t*)(ws + WS_WUKK), KVL, 0, DB * 64, NH * NOPE, KVL, EpiKss{(float*)(ws + WS_IKT)}); }
    xcd_barrier(xbar);
    { PH_WS; const KvPtrs kp = mk_kv(P, ws);
      ph_attn_prompt(P, kp, lds);
      ph_attn_meta(mk_ctx(lds), P, kp);
      ph_attn_sample(P, kp, lds); }
    xcd_barrier(xbar);
    { PH_WS; bf16_t *E_ = (bf16_t*)(ws + WS_E), *Wo = (bf16_t*)(ws + WS_WO), *GA = (bf16_t*)(ws + WS_GA), *GB = (bf16_t*)(ws + WS_GB);
      PH_GEMM(PEpMerge, E_, Wo, TM, D, D, GA, GB)
      ph_gemm_tail<EpiMerge, 4, 4>(lds, E_, D, Wo, D, TM, TOUT, D, D, EpiMerge{GA, GB, 0});
      __syncthreads();
      if (gridDim.x != 256) ph_weights(P, lds, 0x280, (int)blockIdx.x, (int)gridDim.x); else if (blockIdx.x >= 128) ph_weights(P, lds, 0x280, (int)blockIdx.x - 128, 128); }
    xcd_barrier(xbar);
    { PH_WS; bf16_t *GA = (bf16_t*)(ws + WS_GA), *Wout = (bf16_t*)(ws + WS_WOUT), *H1b = (bf16_t*)(ws + WS_GB); float *P2 = (float*)(ws + WS_P2), *P2t = (float*)(ws + WS_P2T);
      PH_GEMM(PEpH1, GA, Wout, TM, D, D, P.in[0], H1b, P2, (PG8_LAS float*)((PG8_LAS unsigned char*)lds + 131072))
      ph_gemm_tail<EpiH1, 4, 4>(lds, GA, D, Wout, D, TM, TOUT, D, D, EpiH1{P.in[1], H1b, P2t});
      __syncthreads();
      if (gridDim.x != 256) ph_weights(P, lds, 0x100, (int)blockIdx.x, (int)gridDim.x); else if (blockIdx.x >= 128) ph_weights(P, lds, 0x100, (int)blockIdx.x - 128, 128); }
    xcd_barrier(xbar);
    { PH_WS; bf16_t *H1b = (bf16_t*)(ws + WS_GB), *Wup = (bf16_t*)(ws + WS_WUP), *A1M = (bf16_t*)(ws + WS_A1M), *A1T = (bf16_t*)(ws + WS_A1T); const float *P2 = (const float*)(ws + WS_P2), *P2t = (const float*)(ws + WS_P2T);
      PH_GEMM(PEpUp, H1b, Wup, TM, DFF, D, A1M, P2)
      ph_gemm_tail<EpiUp, 4, 4>(lds, H1b, D, Wup, D, TM, TOUT, DFF, D, EpiUp{A1T, P2t}); }
    xcd_barrier(xbar);
    { PH_WS; bf16_t *Wdn = (bf16_t*)(ws + WS_WDN), *A1M = (bf16_t*)(ws + WS_A1M), *A1T = (bf16_t*)(ws + WS_A1T), *H1b = (bf16_t*)(ws + WS_GB);
      PH_GEMM(PEpDown, A1M, Wdn, TM, D, DFF, H1b, P.out + OO_Y)
      ph_gemm_tail<EpiDown, 2, 6>(lds, A1T, DFF, Wdn, DFF, 0, TS, D, DFF, EpiDown{H1b, P.out + OO_YS}); }
}

extern "C" void kernel_launch(void* const* d_in, const int* in_sizes, int n_in, void* d_out, int out_size, void* d_ws, size_t ws_size, hipStream_t stream) {
    static int grid_blocks = 0;
    if (n_in != 34 || out_size != (int)OO_END || ws_size < 256 * MiB) { fprintf(stderr, "kernel_launch: unexpected shapes n_in %d out %d ws %zu\n", n_in, out_size, ws_size); return; }
    if (!grid_blocks) {
        int dev = 0, cus = 0, per_cu = 0;
        (void)hipGetDevice(&dev);
        (void)hipDeviceGetAttribute(&cus, hipDeviceAttributeMultiprocessorCount, dev);
        if (hipFuncSetAttribute((const void*)mega_fwd, hipFuncAttributeMaxDynamicSharedMemorySize, LDS_BYTES) != hipSuccess) { fprintf(stderr, "kernel_launch: hipFuncSetAttribute failed\n"); return; }
        if (hipOccupancyMaxActiveBlocksPerMultiprocessor(&per_cu, (const void*)mega_fwd, NTHR, LDS_BYTES) != hipSuccess || per_cu < 1) { fprintf(stderr, "kernel_launch: occupancy query failed (%d)\n", per_cu); return; }
        grid_blocks = cus * per_cu;
        fprintf(stderr, "kernel_launch: %d CUs x %d = grid %d\n", cus, per_cu, grid_blocks);
    }
    Params P{};
    for (int i = 0; i < 34; ++i) P.in[i] = (const float*)d_in[i];
    P.out = (float*)d_out; P.ws = (unsigned char*)d_ws;
    if (hipMemsetAsync((char*)d_ws + WS_BAR, 0, (XCD_BAR_WORDS + DB * NH) * 4, stream) != hipSuccess) { fprintf(stderr, "kernel_launch: memset of the barrier words failed\n"); return; }
    void* args[] = {&P};
    hipError_t e = hipLaunchCooperativeKernel((const void*)mega_fwd, dim3(grid_blocks), dim3(NTHR), args, LDS_BYTES, stream);
    if (e != hipSuccess) fprintf(stderr, "kernel_launch: cooperative launch failed: %s (grid %d)\n", hipGetErrorString(e), grid_blocks);
}
```

```cpp
#include <hip/hip_runtime.h>
#include <hip/hip_cooperative_groups.h>
namespace cg = cooperative_groups;
#include <cstdio>
#include <cstdint>

typedef unsigned short bf16_t;
typedef short bf16x8 __attribute__((ext_vector_type(8)));
typedef float f32x4 __attribute__((ext_vector_type(4)));

constexpr int D = 1024, NB = 4, SEQ = 4096, DB = 16, DS = 32, PAST = 2048;
constexpr int NMETA = 16, NH = 8, NOPE = 128, ROPE = 64, VD = 128, QKD = 192, QL = 384, KVL = 256;
constexpr int NG = 64, GS = 16, NS = 64, DFF = 4096;
constexpr int INC = 3776, O_KV = 384, O_KR = 640, O_SSM = 704, O_GA = 1728, O_GB = 2752, INCP = 3840;
constexpr float EPS = 1e-6f;
constexpr float ATTN_SCALE = 0.07216878364870322f;
constexpr int LP = NMETA + SEQ;

constexpr int TPAD = 67 * 256;
constexpr int TM = NB * SEQ, TS0 = TM, TS = DB * DS, TMETA0 = TS0 + TS, T = TMETA0 + NB * NMETA, TOUT = TMETA0;
constexpr int KV_SC0 = TM, KV_T0 = KV_SC0 + DB * PAST, KV_PM0 = KV_T0, KV_ST0 = KV_T0 + NB * 64, KVR = KV_ST0 + DB * 64, KVT = KVR - KV_T0;

constexpr size_t OO_Y = 0, OO_YS = OO_Y + (size_t)NB * SEQ * D, OO_LATP = OO_YS + (size_t)DB * DS * D, OO_KRP = OO_LATP + (size_t)NB * SEQ * KVL,
                 OO_MLAT = OO_KRP + (size_t)NB * SEQ * ROPE, OO_MKR = OO_MLAT + (size_t)NB * NMETA * KVL, OO_SREP = OO_MKR + (size_t)NB * NMETA * ROPE,
                 OO_SIMP = OO_SREP + (size_t)NB * NG * NS, OO_LATS = OO_SIMP + (size_t)NB * NG * NS, OO_KRS = OO_LATS + (size_t)DB * DS * KVL,
                 OO_SRES = OO_KRS + (size_t)DB * DS * ROPE, OO_SIMS = OO_SRES + (size_t)DB * NG * NS, OO_END = OO_SIMS + (size_t)DB * NG * NS;
static_assert(OO_END == 22892544, "output size");

constexpr size_t MiB = 1u << 20;
constexpr size_t TB = (size_t)T * D * 2;
constexpr size_t WS_BAR = 1 * MiB;
constexpr size_t WS_GKQ = WS_BAR + 32 * 1024;
constexpr size_t WS_P2 = WS_BAR + 128 * 1024, WS_P2T = WS_P2 + (size_t)TM * 4 * 4;
static_assert(WS_P2T + (size_t)TS * 16 * 4 <= 2 * MiB, "control region");
constexpr size_t WS_OLAT = 210 * MiB;
constexpr size_t WS_WP = 197 * MiB;
constexpr size_t WS_WIN = 2 * MiB, WS_WUQ = WS_WIN + (size_t)INCP * D * 2, WS_WUKV = WS_WUQ + (size_t)NH * QKD * QL * 2, WS_WO = WS_WUKV + (size_t)2048 * KVL * 2,
                 WS_WGLU = WS_WO + (size_t)D * D * 2, WS_WOUT = WS_WGLU + (size_t)2 * D * D * 2, WS_WUP = WS_WOUT + (size_t)D * D * 2, WS_WDN = WS_WUP + (size_t)DFF * D * 2,
                 WS_WEND = WS_WDN + (size_t)DFF * D * 2;
static_assert(WS_WEND <= 36 * MiB, "weights");
constexpr size_t WS_WUKK = 1 * MiB + 512 * 1024;
constexpr size_t WS_CF = WS_WOUT;
static_assert(WS_CF + (size_t)DB * PAST * KVL * 2 <= WS_WEND, "CF");
constexpr size_t WS_IKT = 197 * MiB;
constexpr size_t WS_IK = 196 * MiB;
constexpr size_t WS_WUKVB = 0;
static_assert(WS_WUKVB + (size_t)KVL * 2048 * 2 <= 1 * MiB, "wukv copy");
constexpr size_t WS_ROPE = 36 * MiB;
constexpr size_t WS_KR = 37 * MiB + 512 * 1024;
static_assert(WS_ROPE + (size_t)LP * 32 * 2 * 4 <= WS_KR && WS_KR + (size_t)KVR * ROPE * 2 <= 44 * MiB, "small region");
constexpr size_t WS_GA = 44 * MiB, WS_GB = 78 * MiB, WS_E = 112 * MiB;
static_assert(WS_GA + TB <= WS_GB && WS_GB + TB <= WS_E && WS_E + TB <= 146 * MiB, "T buffers");
constexpr size_t WS_F = 146 * MiB;
constexpr size_t WS_ZQ = WS_F, WS_U = WS_ZQ + (size_t)T * O_SSM * 2, WS_CQ = WS_U + TB, WS_CALL = 231 * MiB;
static_assert(WS_CQ + (size_t)T * QL * 2 <= 215 * MiB && WS_CALL + (size_t)KVR * KVL * 2 <= 256 * MiB, "F region P1-P2");
constexpr size_t WS_QM = WS_F;
static_assert(WS_QM + (size_t)TM * NH * QKD * 2 <= WS_CQ, "Qmain vs CQ");
constexpr size_t WS_MATS = 215 * MiB;
constexpr size_t WS_KTAB = WS_MATS, WS_QTAB = WS_KTAB + (size_t)NG * 16 * 256 * 2, WS_PTAB = WS_QTAB + (size_t)NG * 256 * 128 * 2, WS_L16 = WS_PTAB + (size_t)NG * 128 * 256 * 2;
static_assert(WS_L16 + (size_t)NG * NS * 8 <= 231 * MiB, "ssm tables");
constexpr size_t WS_KT = 215 * MiB, WS_VT = WS_KT + (size_t)KVT * D * 2, WS_QT = WS_VT + (size_t)KVT * D * 2;
static_assert(WS_QT + (size_t)(T - TM) * NH * QKD * 2 <= WS_CALL, "tail region");
constexpr size_t WS_VS = WS_F;
static_assert(WS_VS + (size_t)DB * PAST * D * 2 <= WS_KT, "Vs");
constexpr size_t WS_A1T = WS_E, WS_A1M = 128 * MiB;
static_assert(WS_A1T + (size_t)TS * DFF * 2 <= WS_A1M && WS_A1M + (size_t)TM * DFF * 2 <= 256 * MiB, "A1");

__device__ __forceinline__ float bf2f(bf16_t v) { return __uint_as_float((unsigned)v << 16); }
__device__ __forceinline__ bf16_t f2bf(float f) { unsigned u = __float_as_uint(f); return (bf16_t)((u + 0x7fffu + ((u >> 16) & 1u)) >> 16); }
__device__ __forceinline__ float wave_sum(float v) {
#pragma unroll
    for (int o = 1; o < 64; o <<= 1) v += __shfl_xor(v, o);
    return v;
}
__device__ __forceinline__ float wave_max(float v) {
#pragma unroll
    for (int o = 1; o < 64; o <<= 1) v = fmaxf(v, __shfl_xor(v, o));
    return v;
}
__device__ __forceinline__ float sigmoidf_(float x) { const float e = __expf(-x); return fmaf(-e, __builtin_amdgcn_rcpf(1.f + e), 1.f); }
__device__ __forceinline__ float gelu_tanh(float x) { const float u = 0.7978845608028654f * (x + 0.044715f * x * x * x); return 0.5f * x * (1.f + tanhf(u)); }
__device__ __forceinline__ int row_pos(int r) { return r < TM ? (r & (SEQ - 1)) : (r < TMETA0 ? PAST + ((r - TS0) & (DS - 1)) : ((r - TMETA0) & (NMETA - 1)) - NMETA); }
__device__ __forceinline__ int row_kvr(int r) {
    if (r < TM) return r;
    if (r < TMETA0) { const int s = r - TS0; return KV_ST0 + (s >> 5) * 64 + (s & 31); }
    const int s = r - TMETA0; return KV_PM0 + (s >> 4) * 64 + (s & 15);
}

constexpr int LDS_TOP = 163840, TIDTAB_OFF = LDS_TOP - 16 - 256;
__device__ __forceinline__ unsigned hw_slot() { return (unsigned)__builtin_amdgcn_s_getreg((5 << 11) | 4) & 63u; }
__device__ __forceinline__ int my_tid() {
    const int w = *(volatile __attribute__((address_space(3))) int*)(uintptr_t)(TIDTAB_OFF + hw_slot() * 4);
    int l; asm volatile("v_mbcnt_lo_u32_b32 %0, -1, 0\n\tv_mbcnt_hi_u32_b32 %0, -1, %0" : "=v"(l));
    return __builtin_amdgcn_readfirstlane(w) * 64 + l;
}
struct Params {
    const float* in[34];
    float* out;
    unsigned char* ws;
};

namespace pg8 {
#define PG8_LAS __attribute__((address_space(3)))
typedef unsigned short bf16_t;
typedef short bf16x8 __attribute__((ext_vector_type(8)));
typedef float f32x4 __attribute__((ext_vector_type(4)));
typedef unsigned u32x4 __attribute__((ext_vector_type(4)));
constexpr int BM = 256, BK = 64, HALF = 128, HTB = HALF * BK * 2  , STAGE_BYTES = 8 * HTB, NXCD = 8, WGM = 8;

__host__ __device__ __forceinline__ int lds_byte(int r, int c) { const int st = (r >> 4) * 2 + (c >> 5), rr = r & 15, cc = c & 31, ob = rr * 64 + cc * 2; return st * 1024 + (ob ^ (((ob >> 9) & 1) << 5)); }
__host__ __device__ __forceinline__ void stage_rc(int b, int& R, int& C) { const int st = b / 1024, sb = b % 1024, swz = sb ^ (((sb >> 9) & 1) << 5); R = (st >> 1) * 16 + swz / 64; C = (st & 1) * 32 + (swz % 64) / 2; }
__host__ __device__ __forceinline__ int perm32(int rho) { const int n = rho >> 4, i = rho & 15; return 8 * (i >> 2) + 4 * n + (i & 3); }

struct Unit { int pm, pn; };
struct Gemm { const bf16_t* A; const bf16_t* Bt; int M, N, K; };

struct StaticOrder {
    int nM, nN, nwg, G, c;
    __host__ __device__ void init(int M, int N, int G_, int c_) { nM = M / BM; nN = N / BM; nwg = nM * nN; G = G_; c = c_; }
    __host__ __device__ bool next(int i, Unit& u) const {
        const long L = (long)i * G + c; if (L >= nwg) return false;
        int wgid = (int)L; { const int q = nwg / NXCD, r = nwg % NXCD, xcd = wgid % NXCD, off = wgid / NXCD; wgid = (xcd < r ? xcd * (q + 1) : r * (q + 1) + (xcd - r) * q) + off; }
        const int nig = WGM * nN, gid = wgid / nig, fm = gid * WGM, gsz = (nM - fm) < WGM ? (nM - fm) : WGM;
        u.pm = fm + ((wgid % nig) % gsz); u.pn = (wgid % nig) / gsz; return true;
    }
    __device__ __forceinline__ void a_ready(const Unit&) const {}
    __device__ __forceinline__ void done(const Unit&) const {}
};


__device__ __forceinline__ unsigned cvt_pk_bf16(float lo, float hi) { unsigned r; asm volatile("v_cvt_pk_bf16_f32 %0, %1, %2" : "=v"(r) : "v"(lo), "v"(hi)); return r; }
template <class Epi, class Sched, bool ALIGN_EPI = false, bool SP2 = false>
__device__ __forceinline__ void gemm_phase(PG8_LAS unsigned char* lds, const Gemm g, const Sched& S, const Epi& E) {
    int tid_ = my_tid(); asm volatile("" : "+v"(tid_));
    const int tid = tid_, wid = __builtin_amdgcn_readfirstlane(tid >> 6), lane = tid & 63, wr = wid >> 2, wc = wid & 3, fr = lane & 15, fq = lane >> 4;
    int K_ = g.K; asm volatile("" : "+s"(K_));
    const int K = K_, nt = K / BK;
    unsigned voffA[2], voffB[2];
#pragma unroll
    for (int i = 0; i < 2; ++i) { int R, C; stage_rc(tid * 16 + i * 8192, R, C); const int Rb = Epi::PERM ? ((R & ~31) + perm32(R & 31)) : R;
        voffA[i] = (unsigned)(R * K + C) * 2u; voffB[i] = (unsigned)(Rb * K + C) * 2u; }
    const size_t kstep = (size_t)(BK * 2);
    const size_t hstep = (size_t)HALF * K * 2;
    const size_t tstep = 2 * hstep;
    const unsigned ldsw = (unsigned)wid * 1024u;
    const int aoff = lds_byte(wr * 64 + fr, fq * 8), boff = lds_byte(wc * 32 + fr, fq * 8);
#define PG8_SA(b, h) (((b) * 2 + (h)) * HTB)
#define PG8_SB(b, h) ((4 + (b) * 2 + (h)) * HTB)
#define PG8_STAGE(bufoff, gbase, voff) do { _Pragma("unroll") for (int _i = 0; _i < 2; ++_i) \
        __builtin_amdgcn_global_load_lds((const unsigned*)((const char*)(gbase) + (voff)[_i]), (PG8_LAS unsigned*)(lds + (bufoff) + ldsw + _i * 8192), 16, 0, 0); } while (0)
#define PG8_LDA(dst, b, h) do { _Pragma("unroll") for (int m = 0; m < 4; ++m) _Pragma("unroll") for (int k = 0; k < 2; ++k) dst[m][k] = *(const PG8_LAS bf16x8*)(lds + PG8_SA(b, h) + aoff + m * 2048 + k * 1024); } while (0)
#define PG8_LDB(dst, b, h) do { _Pragma("unroll") for (int n = 0; n < 2; ++n) _Pragma("unroll") for (int k = 0; k < 2; ++k) dst[n][k] = *(const PG8_LAS bf16x8*)(lds + PG8_SB(b, h) + boff + n * 2048 + k * 1024); } while (0)
#define PG8_MMA(ai, bj, At, Bt) do { __builtin_amdgcn_s_setprio(1); _Pragma("unroll") for (int m = 0; m < 4; ++m) _Pragma("unroll") for (int n = 0; n < 2; ++n) _Pragma("unroll") for (int k = 0; k < 2; ++k) \
        acc[ai][bj][m][n] = __builtin_amdgcn_mfma_f32_16x16x32_bf16(Bt[n][k], At[m][k], acc[ai][bj][m][n], 0, 0, 0); __builtin_amdgcn_s_setprio(0); } while (0)
#define PG8_WAIT_V(n) asm volatile("s_waitcnt vmcnt(" #n ")" ::: "memory")
#define PG8_WAIT_L(n) asm volatile("s_waitcnt lgkmcnt(" #n ")" ::: "memory")
#define PG8_BAR __builtin_amdgcn_s_barrier()
#define PG8_SCHED __builtin_amdgcn_sched_barrier(0)
    Unit cur, nxt; int ui = 0;
    if (!S.next(0, cur)) return;
    f32x4 acc[2][2][4][2];
#pragma unroll
    for (int a = 0; a < 2; ++a)
#pragma unroll
        for (int b = 0; b < 2; ++b)
#pragma unroll
            for (int m = 0; m < 4; ++m)
#pragma unroll
                for (int n = 0; n < 2; ++n) acc[a][b][m][n] = (f32x4){0.f, 0.f, 0.f, 0.f};
    bf16x8 At[4][2], B0[2][2], B1[2][2];
    const char* cA = (const char*)g.A + (size_t)cur.pm * tstep; const char* cB = (const char*)g.Bt + (size_t)cur.pn * tstep;
    S.a_ready(cur);
    if constexpr (SP2) {
        PG8_STAGE(PG8_SB(0, 0), cB, voffB); PG8_STAGE(PG8_SB(0, 1), cB + hstep, voffB); PG8_STAGE(PG8_SA(0, 0), cA, voffA); PG8_STAGE(PG8_SA(0, 1), cA + hstep, voffA);
        if (wr == 1) PG8_BAR;
        PG8_WAIT_V(2); PG8_BAR;
        PG8_STAGE(PG8_SB(1, 0), cB + kstep, voffB); PG8_STAGE(PG8_SA(1, 0), cA + kstep, voffA); PG8_STAGE(PG8_SB(1, 1), cB + hstep + kstep, voffB);
        PG8_WAIT_V(6); PG8_BAR;
    } else {
        PG8_STAGE(PG8_SB(0, 0), cB, voffB); PG8_STAGE(PG8_SA(0, 0), cA, voffA); PG8_STAGE(PG8_SB(0, 1), cB + hstep, voffB); PG8_STAGE(PG8_SA(0, 1), cA + hstep, voffA);
        if (wr == 1) PG8_BAR;
        PG8_WAIT_V(4); PG8_BAR;
        PG8_STAGE(PG8_SB(1, 0), cB + kstep, voffB); PG8_STAGE(PG8_SA(1, 0), cA + kstep, voffA); PG8_STAGE(PG8_SB(1, 1), cB + hstep + kstep, voffB);
        PG8_WAIT_V(6); PG8_BAR;
    }
    for (;;) {
        const bool has_next = S.next(ui + 1, nxt);
        const char* nA = has_next ? (const char*)g.A + (size_t)nxt.pm * tstep : cA; const char* nB = has_next ? (const char*)g.Bt + (size_t)nxt.pn * tstep : cB;
        for (int t = 0; t < nt; t += 2) {
            const bool last = (t == nt - 2);
            const char* a1 = cA + (size_t)(t + 1) * kstep;
            const char* a2 = last ? nA : cA + (size_t)(t + 2) * kstep; const char* b2 = last ? nB : cB + (size_t)(t + 2) * kstep;
            const char* a3 = a2 + kstep; const char* b3 = b2 + kstep;
            if (last && has_next) S.a_ready(nxt);
            if constexpr (SP2) {
            PG8_LDB(B0, 0, 0); PG8_LDB(B1, 0, 1); PG8_SCHED; PG8_LDA(At, 0, 0); PG8_STAGE(PG8_SA(1, 1), a1 + hstep, voffA);
            PG8_WAIT_V(8); PG8_WAIT_L(0); PG8_BAR; PG8_MMA(0, 0, At, B0); PG8_MMA(0, 1, At, B1); PG8_BAR; PG8_SCHED;
            PG8_LDA(At, 0, 1); PG8_STAGE(PG8_SB(0, 0), b2, voffB); PG8_STAGE(PG8_SB(0, 1), b2 + hstep, voffB); PG8_STAGE(PG8_SA(0, 0), a2, voffA);
            PG8_WAIT_V(8); PG8_WAIT_L(0); PG8_BAR; PG8_MMA(1, 0, At, B0); PG8_MMA(1, 1, At, B1); PG8_BAR; PG8_SCHED;
            PG8_LDB(B0, 1, 0); PG8_LDB(B1, 1, 1); PG8_SCHED; PG8_LDA(At, 1, 0); PG8_STAGE(PG8_SA(0, 1), a2 + hstep, voffA);
            PG8_WAIT_V(8); PG8_WAIT_L(0); PG8_BAR; PG8_MMA(0, 0, At, B0); PG8_MMA(0, 1, At, B1); PG8_BAR; PG8_SCHED;
            PG8_LDA(At, 1, 1); PG8_STAGE(PG8_SB(1, 0), b3, voffB); PG8_STAGE(PG8_SB(1, 1), b3 + hstep, voffB); PG8_STAGE(PG8_SA(1, 0), a3, voffA);
            PG8_WAIT_V(8); PG8_WAIT_L(0); PG8_BAR; PG8_MMA(1, 0, At, B0); PG8_MMA(1, 1, At, B1); PG8_BAR; PG8_SCHED;
            } else {
            PG8_LDB(B0, 0, 0); PG8_SCHED; PG8_LDA(At, 0, 0); PG8_STAGE(PG8_SA(1, 1), a1 + hstep, voffA);
            PG8_WAIT_L(8); PG8_BAR; PG8_WAIT_L(0); PG8_MMA(0, 0, At, B0); PG8_BAR; PG8_SCHED;
            PG8_LDB(B1, 0, 1); PG8_STAGE(PG8_SB(0, 0), b2, voffB);
            PG8_BAR; PG8_WAIT_L(0); PG8_MMA(0, 1, At, B1); PG8_BAR;
            PG8_LDA(At, 0, 1); PG8_STAGE(PG8_SA(0, 0), a2, voffA);
            PG8_BAR; PG8_WAIT_L(0); PG8_MMA(1, 0, At, B0); PG8_BAR; PG8_SCHED;
            PG8_STAGE(PG8_SB(0, 1), b2 + hstep, voffB);
            PG8_WAIT_V(6); PG8_BAR; PG8_MMA(1, 1, At, B1); PG8_BAR;
            PG8_LDB(B0, 1, 0); PG8_SCHED; PG8_LDA(At, 1, 0); PG8_STAGE(PG8_SA(0, 1), a2 + hstep, voffA);
            PG8_WAIT_L(8); PG8_BAR; PG8_WAIT_L(0); PG8_MMA(0, 0, At, B0); PG8_BAR; PG8_SCHED;
            PG8_LDB(B1, 1, 1); PG8_STAGE(PG8_SB(1, 0), b3, voffB);
            PG8_BAR; PG8_WAIT_L(0); PG8_MMA(0, 1, At, B1); PG8_BAR;
            PG8_LDA(At, 1, 1); PG8_STAGE(PG8_SA(1, 0), a3, voffA);
            PG8_BAR; PG8_WAIT_L(0); PG8_MMA(1, 0, At, B0); PG8_BAR; PG8_SCHED;
            PG8_STAGE(PG8_SB(1, 1), b3 + hstep, voffB);
            PG8_WAIT_V(6); PG8_BAR; PG8_MMA(1, 1, At, B1); PG8_BAR;
            }
        }
        if constexpr (ALIGN_EPI) { if (wr == 0) PG8_BAR; }
        if constexpr (!Epi::AFTER_DRAIN) { E(acc, cur, wr, wc, fr, fq); S.done(cur); }
        if (!has_next) break;
#pragma unroll
        for (int a = 0; a < 2; ++a)
#pragma unroll
            for (int b = 0; b < 2; ++b)
#pragma unroll
                for (int m = 0; m < 4; ++m)
#pragma unroll
                    for (int n = 0; n < 2; ++n) acc[a][b][m][n] = (f32x4){0.f, 0.f, 0.f, 0.f};
        cur = nxt; cA = nA; cB = nB; ++ui;
        if constexpr (ALIGN_EPI) { if (wr == 1) PG8_BAR; }
    }
    PG8_WAIT_V(0);
    if constexpr (!ALIGN_EPI) { if (wr == 0) PG8_BAR; }
    PG8_BAR;
    if constexpr (Epi::AFTER_DRAIN) { E.fused(acc, cur, wr, wc, fr, fq, lds, wid, lane); S.done(cur); }
#undef PG8_SA
#undef PG8_SB
#undef PG8_STAGE
#undef PG8_LDA
#undef PG8_LDB
#undef PG8_MMA
#undef PG8_WAIT_V
#undef PG8_WAIT_L
#undef PG8_BAR
#undef PG8_SCHED
}
}

constexpr int NTHR = 512, NWV = NTHR / 64;
constexpr int LDS_BYTES = 163840;
namespace att {
typedef __attribute__((address_space(3))) unsigned char lds_t;
using s16x4  = __attribute__((ext_vector_type(4))) short;
using f32x16 = __attribute__((ext_vector_type(16))) float;
using u32x4  = __attribute__((ext_vector_type(4))) unsigned;
#define ATT_SBAR() __builtin_amdgcn_sched_barrier(0)
constexpr float THR = 8.f;
constexpr int VBUF = 16384, KBUF = 24576, NVB = 4, NKB = 3, OFF_V = 0, OFF_K = NVB * VBUF, OFF_KN = 0, OFF_KR = 16384, OFF_WS = OFF_K + NKB * KBUF, LDS_NEED = OFF_WS + NWV * 256;
__device__ __forceinline__ int crow(int r, int hi) { return (r & 3) + 8 * (r >> 2) + 4 * hi; }
__device__ __forceinline__ unsigned cvtpk(float lo, float hi) { unsigned r; asm volatile("v_cvt_pk_bf16_f32 %0, %1, %2" : "=v"(r) : "v"(lo), "v"(hi)); return r; }
__device__ __forceinline__ int kn_off(int row, int c16) { return row * 256 + ((c16 ^ (row & 15)) << 4); }
__device__ __forceinline__ int kr_off(int row, int c16) { return row * 128 + ((c16 ^ ((row >> 1) & 7)) << 4); }
__device__ __forceinline__ int v_st(int k, int c) { const int kk = (k & ~0xC) | ((k & 4) << 1) | ((k & 8) >> 1); return ((kk >> 3) * 4 + (c >> 5)) * 512 + ((kk & 7) * 32 + (c & 31)) * 2; }
__device__ __forceinline__ int v_rd_base(int lane) { return ((lane & 3) << 3) | (((lane >> 2) & 3) << 6) | (((lane >> 4) & 1) << 5) | (((lane >> 5) & 1) << 8); }
constexpr int v_rd_off(int d0, int ks, int half) { return d0 * 512 + ks * 4096 + half * 2048; }
template <int OFF> __device__ __forceinline__ s16x4 tr_read(unsigned vb) { s16x4 r; asm volatile("ds_read_b64_tr_b16 %0, %1 offset:%2" : "=&v"(r) : "v"(vb), "i"(OFF) : "memory"); return r; }

__device__ __forceinline__ void partialSM(f32x16& p0, f32x16& p1, float& m_reg, float& alpha) {
    constexpr float C = ATTN_SCALE * 1.4426950408889634f;
    float ma = fmaxf(p0[0], p0[1]), mb = fmaxf(p0[2], p0[3]), mc = fmaxf(p1[0], p1[1]), md = fmaxf(p1[2], p1[3]);
#pragma unroll
    for (int r = 4; r < 16; r += 4) { ma = fmaxf(ma, fmaxf(p0[r], p0[r + 1])); mb = fmaxf(mb, fmaxf(p0[r + 2], p0[r + 3])); mc = fmaxf(mc, fmaxf(p1[r], p1[r + 1])); md = fmaxf(md, fmaxf(p1[r + 2], p1[r + 3])); }
    float pmax = fmaxf(fmaxf(ma, mb), fmaxf(mc, md));
    { auto rr = __builtin_amdgcn_permlane32_swap(__float_as_uint(pmax), __float_as_uint(pmax), false, false); pmax = fmaxf(__uint_as_float(rr[0]), __uint_as_float(rr[1])); }
    float mn;
    if (__all(pmax - m_reg <= THR / ATTN_SCALE)) { mn = m_reg; alpha = 1.f; }
    else { mn = fmaxf(m_reg, pmax); alpha = __builtin_amdgcn_exp2f((m_reg - mn) * C); m_reg = mn; }
    const float mnC = -mn * C;
#pragma unroll
    for (int r = 0; r < 16; ++r) { p0[r] = __builtin_amdgcn_exp2f(fmaf(p0[r], C, mnC)); p1[r] = __builtin_amdgcn_exp2f(fmaf(p1[r], C, mnC)); }
}
__device__ __forceinline__ void finishSM(const f32x16& p0, const f32x16& p1, float alpha, float& l_reg, bf16x8& pa0, bf16x8& pa1, bf16x8& pa2, bf16x8& pa3) {
    float sa = p0[0] + p0[1], sb = p0[2] + p0[3], sc = p1[0] + p1[1], sd = p1[2] + p1[3];
#pragma unroll
    for (int r = 4; r < 16; r += 4) { sa += p0[r] + p0[r + 1]; sb += p0[r + 2] + p0[r + 3]; sc += p1[r] + p1[r + 1]; sd += p1[r + 2] + p1[r + 3]; }
    float ps = (sa + sb) + (sc + sd);
    { auto rr = __builtin_amdgcn_permlane32_swap(__float_as_uint(ps), __float_as_uint(ps), false, false); ps = __uint_as_float(rr[0]) + __uint_as_float(rr[1]); }
    l_reg = l_reg * alpha + ps;
#define ATT_PK4(P, BASE, OUT) do { unsigned a0 = cvtpk(P[BASE + 0], P[BASE + 1]), a1 = cvtpk(P[BASE + 2], P[BASE + 3]);   \
    unsigned b0 = cvtpk(P[BASE + 4], P[BASE + 5]), b1 = cvtpk(P[BASE + 6], P[BASE + 7]);                              \
    auto r0 = __builtin_amdgcn_permlane32_swap(a0, b0, false, false); auto r1 = __builtin_amdgcn_permlane32_swap(a1, b1, false, false); \
    u32x4 w = {r0[0], r1[0], r0[1], r1[1]}; OUT = __builtin_bit_cast(bf16x8, w); } while (0)
    ATT_PK4(p0, 0, pa0); ATT_PK4(p0, 8, pa1); ATT_PK4(p1, 0, pa2); ATT_PK4(p1, 8, pa3);
#undef ATT_PK4
}
#define ATT_KRD2(d0_, d1_, addr, OFFB) asm volatile("ds_read_b128 %0, %2\n\tds_read_b128 %1, %2 offset:" #OFFB : "=&v"(d0_), "=&v"(d1_) : "v"(addr))
__device__ __forceinline__ void qkt(f32x16& p0, f32x16& p1, lds_t* buf, const bf16x8 (&qr)[12], int r32, int hi) {
    p0 = f32x16{}; p1 = f32x16{};
    const unsigned kb = (unsigned)(uintptr_t)buf;
    const unsigned x = r32 & 15, nb0 = kb + OFF_KN + r32 * 256 + ((hi ^ (x & 1)) << 4), na = (x >> 1) << 5;
    const unsigned rb0 = kb + OFF_KR + r32 * 128, ra = ((r32 >> 1) & 7) << 4, rh = hi << 4;
#define ATT_KADDR(step) ((step) < 8 ? nb0 + (na ^ (unsigned)((step) << 5)) : rb0 + (ra ^ ((unsigned)(((step) - 8) << 5) | rh)))
    bf16x8 f0[3], f1[3];
    ATT_KRD2(f0[0], f1[0], ATT_KADDR(0), 8192); ATT_KRD2(f0[1], f1[1], ATT_KADDR(1), 8192);
#pragma unroll
    for (int d0 = 0; d0 < 12; ++d0) {
        if (d0 + 2 < 12) { if (d0 + 2 < 8) ATT_KRD2(f0[(d0 + 2) % 3], f1[(d0 + 2) % 3], ATT_KADDR(d0 + 2), 8192); else ATT_KRD2(f0[(d0 + 2) % 3], f1[(d0 + 2) % 3], ATT_KADDR(d0 + 2), 4096); }
        if (d0 <= 9) asm volatile("s_waitcnt lgkmcnt(4)" ::: "memory"); else if (d0 == 10) asm volatile("s_waitcnt lgkmcnt(2)" ::: "memory"); else asm volatile("s_waitcnt lgkmcnt(0)" ::: "memory");
        ATT_SBAR();
        p0 = __builtin_amdgcn_mfma_f32_32x32x16_bf16(f0[d0 % 3], qr[d0], p0, 0, 0, 0);
        p1 = __builtin_amdgcn_mfma_f32_32x32x16_bf16(f1[d0 % 3], qr[d0], p1, 0, 0, 0);
    }
#undef ATT_KADDR
}
template <int D0> __device__ __forceinline__ void pv_one(f32x16& od, unsigned vb, bf16x8 pa0, bf16x8 pa1, bf16x8 pa2, bf16x8 pa3) {
    const s16x4 l0 = tr_read<v_rd_off(D0, 0, 0)>(vb), h0 = tr_read<v_rd_off(D0, 0, 1)>(vb), l1 = tr_read<v_rd_off(D0, 1, 0)>(vb), h1 = tr_read<v_rd_off(D0, 1, 1)>(vb);
    const s16x4 l2 = tr_read<v_rd_off(D0, 2, 0)>(vb), h2 = tr_read<v_rd_off(D0, 2, 1)>(vb), l3 = tr_read<v_rd_off(D0, 3, 0)>(vb), h3 = tr_read<v_rd_off(D0, 3, 1)>(vb);
    asm volatile("s_waitcnt lgkmcnt(0)" ::: "memory"); ATT_SBAR();
#define ATT_PK(L, H) (bf16x8){L[0], L[1], L[2], L[3], H[0], H[1], H[2], H[3]}
    od = __builtin_amdgcn_mfma_f32_32x32x16_bf16(pa0, ATT_PK(l0, h0), od, 0, 0, 0);
    od = __builtin_amdgcn_mfma_f32_32x32x16_bf16(pa1, ATT_PK(l1, h1), od, 0, 0, 0);
    od = __builtin_amdgcn_mfma_f32_32x32x16_bf16(pa2, ATT_PK(l2, h2), od, 0, 0, 0);
    od = __builtin_amdgcn_mfma_f32_32x32x16_bf16(pa3, ATT_PK(l3, h3), od, 0, 0, 0);
#undef ATT_PK
}

template <class T> __device__ __forceinline__ T* uni_ptr(T* p) { const unsigned long long v = (unsigned long long)p; const unsigned lo = __builtin_amdgcn_readfirstlane((unsigned)v), hi = __builtin_amdgcn_readfirstlane((unsigned)(v >> 32)); return (T*)(((unsigned long long)hi << 32) | lo); }
template <class T> __device__ __forceinline__ T* opq_ptr(T* p) { asm volatile("" : "+s"(p)); return p; }
__device__ __forceinline__ int uni_int(int v) { return __builtin_amdgcn_readfirstlane(v); }
struct Unit {
    const bf16_t* Q; bf16_t* O;
    const bf16_t *K0, *V0, *KR0, *K1, *V1, *KR1; int n0, n1;
    int jm, nv;
    int nact, lim0, lstep;
    int raw0, raw1;
    int pos0;
    const float *gqn, *gqr, *gkn, *rtab;
    unsigned* cnt; const bf16_t* WV; bf16_t* O2;
    const float* IK1;
    const float* IK0; const bf16_t* WB;
};
__device__ __forceinline__ float xsum32(float v) { auto rr = __builtin_amdgcn_permlane32_swap(__float_as_uint(v), __float_as_uint(v), false, false); return __uint_as_float(rr[0]) + __uint_as_float(rr[1]); }
__device__ __forceinline__ void load_q(const Unit& U, const bf16_t* Qw, int pos, int hi, bf16x8 (&qr)[12]) {
#pragma unroll
        for (int d0 = 0; d0 < 12; ++d0) qr[d0] = *(const bf16x8*)(Qw + d0 * 16);
        const float* tb = U.rtab + ((size_t)(pos + NMETA) * 32 + hi * 8) * 2;
        f32x4 tv[2][4], ga[2][2], gb[2][2];
#pragma unroll
        for (int dd = 0; dd < 2; ++dd) {
#pragma unroll
            for (int i = 0; i < 4; ++i) tv[dd][i] = *(const f32x4*)(tb + dd * 32 + i * 4);
            ga[dd][0] = *(const f32x4*)(U.gqr + dd * 16 + hi * 8); ga[dd][1] = *(const f32x4*)(U.gqr + dd * 16 + hi * 8 + 4);
            gb[dd][0] = *(const f32x4*)(U.gqr + 32 + dd * 16 + hi * 8); gb[dd][1] = *(const f32x4*)(U.gqr + 32 + dd * 16 + hi * 8 + 4); }
        float sn = 0.f, sr_ = 0.f;
#pragma unroll
        for (int d0 = 0; d0 < 12; ++d0)
#pragma unroll
            for (int e = 0; e < 8; ++e) { const float v = bf2f((bf16_t)qr[d0][e]); if (d0 < 8) sn += v * v; else sr_ += v * v; }
        sn = xsum32(sn); sr_ = xsum32(sr_);
        const float rn = rsqrtf(sn * (1.f / NOPE) + EPS), rr = rsqrtf(sr_ * (1.f / ROPE) + EPS);
#pragma unroll
        for (int d0 = 0; d0 < 8; ++d0) { u32x4 w;
            w.x = cvtpk(bf2f((bf16_t)qr[d0][0]) * rn, bf2f((bf16_t)qr[d0][1]) * rn); w.y = cvtpk(bf2f((bf16_t)qr[d0][2]) * rn, bf2f((bf16_t)qr[d0][3]) * rn);
            w.z = cvtpk(bf2f((bf16_t)qr[d0][4]) * rn, bf2f((bf16_t)qr[d0][5]) * rn); w.w = cvtpk(bf2f((bf16_t)qr[d0][6]) * rn, bf2f((bf16_t)qr[d0][7]) * rn);
            qr[d0] = __builtin_bit_cast(bf16x8, w); }
#pragma unroll
        for (int dd = 0; dd < 2; ++dd) {
            float lo[8], hh[8];
#pragma unroll
            for (int e = 0; e < 8; ++e) {
                const float ya = bf2f((bf16_t)qr[8 + dd][e]) * rr * ga[dd][e >> 2][e & 3], yb = bf2f((bf16_t)qr[10 + dd][e]) * rr * gb[dd][e >> 2][e & 3];
                const float c = tv[dd][e >> 1][(e & 1) * 2], s = tv[dd][e >> 1][(e & 1) * 2 + 1];
                lo[e] = ya * c - yb * s; hh[e] = yb * c + ya * s; }
            u32x4 wl, wh; wl.x = cvtpk(lo[0], lo[1]); wl.y = cvtpk(lo[2], lo[3]); wl.z = cvtpk(lo[4], lo[5]); wl.w = cvtpk(lo[6], lo[7]);
            wh.x = cvtpk(hh[0], hh[1]); wh.y = cvtpk(hh[2], hh[3]); wh.z = cvtpk(hh[4], hh[5]); wh.w = cvtpk(hh[6], hh[7]);
            qr[8 + dd] = __builtin_bit_cast(bf16x8, wl); qr[10 + dd] = __builtin_bit_cast(bf16x8, wh); }
}
__device__ __forceinline__ void run_unit(const Unit& U_, lds_t* lds) {
    Unit U;
    U.Q = uni_ptr(U_.Q); U.O = uni_ptr(U_.O); U.K0 = uni_ptr(U_.K0); U.V0 = uni_ptr(U_.V0); U.KR0 = uni_ptr(U_.KR0); U.K1 = uni_ptr(U_.K1); U.V1 = uni_ptr(U_.V1); U.KR1 = uni_ptr(U_.KR1);
    U.n0 = uni_int(U_.n0); U.n1 = uni_int(U_.n1); U.jm = uni_int(U_.jm); U.nv = uni_int(U_.nv); U.nact = uni_int(U_.nact); U.lim0 = uni_int(U_.lim0); U.lstep = uni_int(U_.lstep);
    U.raw0 = uni_int(U_.raw0); U.raw1 = uni_int(U_.raw1); U.pos0 = uni_int(U_.pos0); U.gqn = uni_ptr(U_.gqn); U.gqr = uni_ptr(U_.gqr); U.gkn = uni_ptr(U_.gkn); U.rtab = uni_ptr(U_.rtab);
    int tid_ = my_tid(); asm volatile("" : "+v"(tid_));
    const int tid = tid_, wid = __builtin_amdgcn_readfirstlane(tid >> 6), lane = tid & 63, r32 = lane & 31, hi = lane >> 5;
    const int NT = U.n0 + U.n1;
    const int lim = wid < U.nact ? U.lim0 + (wid >> 1) * U.lstep : 0;
    __attribute__((address_space(3))) float* al_l = (__attribute__((address_space(3))) float*)(lds + OFF_WS + wid * 256);
    __attribute__((address_space(3))) float* li_l = al_l + 32;
    float m_reg = -1e30f, l_reg = 0.f; f32x16 o[4] = {}; bf16x8 qr[12];
    const int sr = tid >> 4, sc = (tid & 15) * 8, kr_r = tid >> 3, kr_c = tid & 7;
    const int vst0 = v_st(sr, sc), vst1 = v_st(32 + sr, sc), kst0 = kn_off(sr, sc >> 3), kst1 = kn_off(32 + sr, sc >> 3), krst = kr_off(kr_r, kr_c);
    const unsigned vb0 = (unsigned)(uintptr_t)(lds + OFF_V) + (unsigned)v_rd_base(lane);
    bf16x8 sk0, sk1, sv0, sv1, skr;
#define ATT_SLOAD(j) do { const int j_ = (j); const bool s0_ = j_ < U.n0; const size_t ro_ = (size_t)(s0_ ? j_ : j_ - U.n0) * 64; \
        const bf16_t* Kt_ = (s0_ ? U.K0 : U.K1) + ro_ * D; const bf16_t* Vt_ = (s0_ ? U.V0 : U.V1) + ro_ * D; const bf16_t* Rt_ = (s0_ ? U.KR0 : U.KR1) + ro_ * ROPE; \
        sk0 = *(const bf16x8*)(Kt_ + (size_t)sr * D + sc); sk1 = *(const bf16x8*)(Kt_ + (size_t)(32 + sr) * D + sc); \
        sv0 = *(const bf16x8*)(Vt_ + (size_t)sr * D + sc); sv1 = *(const bf16x8*)(Vt_ + (size_t)(32 + sr) * D + sc); \
        skr = *(const bf16x8*)(Rt_ + (size_t)kr_r * ROPE + kr_c * 8); } while (0)
#define ATT_KNORM(kx) do { float f_[8]; float ss_ = 0.f; _Pragma("unroll") for (int e = 0; e < 8; ++e) { f_[e] = bf2f((bf16_t)kx[e]); ss_ += f_[e] * f_[e]; } \
        ss_ += __shfl_xor(ss_, 1); ss_ += __shfl_xor(ss_, 2); ss_ += __shfl_xor(ss_, 4); ss_ += __shfl_xor(ss_, 8); const float rs_ = rsqrtf(ss_ * (1.f / NOPE) + EPS); \
        u32x4 w_; w_.x = cvtpk(f_[0] * rs_ * U.gkn[sc + 0], f_[1] * rs_ * U.gkn[sc + 1]); w_.y = cvtpk(f_[2] * rs_ * U.gkn[sc + 2], f_[3] * rs_ * U.gkn[sc + 3]); \
        w_.z = cvtpk(f_[4] * rs_ * U.gkn[sc + 4], f_[5] * rs_ * U.gkn[sc + 5]); w_.w = cvtpk(f_[6] * rs_ * U.gkn[sc + 6], f_[7] * rs_ * U.gkn[sc + 7]); kx = __builtin_bit_cast(bf16x8, w_); } while (0)
#define ATT_SWRITE(vb_, kb_, j) do { lds_t* V_ = lds + OFF_V + (vb_) * VBUF; lds_t* K_ = lds + OFF_K + (kb_) * KBUF; if (((j) < U.n0) ? U.raw0 : U.raw1) { ATT_KNORM(sk0); ATT_KNORM(sk1); } \
        *(__attribute__((address_space(3))) bf16x8*)(V_ + vst0) = sv0; *(__attribute__((address_space(3))) bf16x8*)(V_ + vst1) = sv1; \
        *(__attribute__((address_space(3))) bf16x8*)(K_ + OFF_KN + kst0) = sk0; *(__attribute__((address_space(3))) bf16x8*)(K_ + OFF_KN + kst1) = sk1; \
        *(__attribute__((address_space(3))) bf16x8*)(K_ + OFF_KR + krst) = skr; } while (0)
    const int dsl0 = wid * 64 + lane, dsl1 = 512 + dsl0;
    unsigned gk0, gk1, gv0, gv1, gkr;
    { const int r0_ = dsl0 >> 4, r1_ = dsl1 >> 4; gk0 = (unsigned)(r0_ * D + (((dsl0 & 15) ^ (r0_ & 15)) << 3)); gk1 = (unsigned)(r1_ * D + (((dsl1 & 15) ^ (r1_ & 15)) << 3));
      const int rr_ = dsl0 >> 3; gkr = (unsigned)(rr_ * ROPE + (((dsl0 & 7) ^ ((rr_ >> 1) & 7)) << 3));
      auto vsrc = [](int s) { const int sub = s >> 5, within = s & 31, kk = (sub >> 2) * 8 + (within >> 2), k = (kk & ~0xC) | ((kk & 4) << 1) | ((kk & 8) >> 1), c = (sub & 3) * 32 + (within & 3) * 8; return (unsigned)(k * D + c); };
      gv0 = vsrc(dsl0); gv1 = vsrc(dsl1); }
#define ATT_DMA(vb_, kb_, j) do { const int j_ = (j); const bool s0_ = j_ < U.n0; const size_t ro_ = (size_t)(s0_ ? j_ : j_ - U.n0) * 64; \
        const bf16_t* Kt_ = (s0_ ? U.K0 : U.K1) + ro_ * D; const bf16_t* Vt_ = (s0_ ? U.V0 : U.V1) + ro_ * D; const bf16_t* Rt_ = (s0_ ? U.KR0 : U.KR1) + ro_ * ROPE; \
        lds_t* V_ = lds + OFF_V + (vb_) * VBUF + wid * 1024; lds_t* K_ = lds + OFF_K + (kb_) * KBUF + wid * 1024; \
        __builtin_amdgcn_global_load_lds((const unsigned*)(Kt_ + gk0), (__attribute__((address_space(3))) unsigned*)(K_ + OFF_KN), 16, 0, 0); \
        __builtin_amdgcn_global_load_lds((const unsigned*)(Kt_ + gk1), (__attribute__((address_space(3))) unsigned*)(K_ + OFF_KN + 8192), 16, 0, 0); \
        __builtin_amdgcn_global_load_lds((const unsigned*)(Vt_ + gv0), (__attribute__((address_space(3))) unsigned*)(V_), 16, 0, 0); \
        __builtin_amdgcn_global_load_lds((const unsigned*)(Vt_ + gv1), (__attribute__((address_space(3))) unsigned*)(V_ + 8192), 16, 0, 0); \
        __builtin_amdgcn_global_load_lds((const unsigned*)(Rt_ + gkr), (__attribute__((address_space(3))) unsigned*)(K_ + OFF_KR), 16, 0, 0); } while (0)
    const bool roleB = wid >= 4;
    bf16x8 pa0 = {}, pa1 = {}, pa2 = {}, pa3 = {};
    __syncthreads();
    ATT_SLOAD(0);
    if (1 < NT) ATT_DMA(1, 1, 1);
    if (lim > 0) {
        load_q(U, U.Q + (size_t)(wid * 32 + r32) * (NH * QKD) + hi * 8, U.pos0 + wid * 32 + r32, hi, qr);
    } else {
#pragma unroll
        for (int d0 = 0; d0 < 12; ++d0) qr[d0] = bf16x8{};
    }
    ATT_SWRITE(0, 0, 0);
    asm volatile("s_waitcnt vmcnt(0) lgkmcnt(0)" ::: "memory"); __builtin_amdgcn_s_barrier(); asm volatile("" ::: "memory");
    int kcur = 0;
    for (int jj = 0; jj <= NT; ++jj) {
        const int vcur = jj & 3, vprv = (jj - 1) & 3, k2 = kcur == 0 ? 2 : kcur - 1;
        if (jj + 2 < NT) ATT_DMA((jj + 2) & 3, k2, jj + 2);
        const bool doQK = jj < NT && jj < lim;
        if (roleB && jj >= 1 && jj - 1 < lim) { const unsigned vb = vb0 + (unsigned)(vprv * VBUF); __builtin_amdgcn_s_setprio(1);
            pv_one<0>(o[0], vb, pa0, pa1, pa2, pa3); pv_one<1>(o[1], vb, pa0, pa1, pa2, pa3); pv_one<2>(o[2], vb, pa0, pa1, pa2, pa3); pv_one<3>(o[3], vb, pa0, pa1, pa2, pa3); __builtin_amdgcn_s_setprio(0); }
        if (doQK) {
            f32x16 p0, p1; float alpha;
            __builtin_amdgcn_s_setprio(1); qkt(p0, p1, lds + OFF_K + kcur * KBUF, qr, r32, hi); __builtin_amdgcn_s_setprio(0);
            if (jj == U.jm) { const int kb_ = 4 * hi;
#pragma unroll
                for (int r = 0; r < 16; ++r) { const int kv = kb_ + (r & 3) + 8 * (r >> 2); if (kv >= U.nv) p0[r] = -INFINITY; if (kv + 32 >= U.nv) p1[r] = -INFINITY; } }
            partialSM(p0, p1, m_reg, alpha);
            if (__any(alpha < 1.f)) {
                if (hi == 0) al_l[r32] = alpha;
                asm volatile("s_waitcnt lgkmcnt(0)" ::: "memory");
#pragma unroll
                for (int r = 0; r < 16; ++r) { const float a = al_l[crow(r, hi)];
#pragma unroll
                    for (int d = 0; d < 4; ++d) o[d][r] *= a; }
            }
            finishSM(p0, p1, alpha, l_reg, pa0, pa1, pa2, pa3);
        }
        if (!roleB && doQK) { const unsigned vb = vb0 + (unsigned)(vcur * VBUF); __builtin_amdgcn_s_setprio(1);
            pv_one<0>(o[0], vb, pa0, pa1, pa2, pa3); pv_one<1>(o[1], vb, pa0, pa1, pa2, pa3); pv_one<2>(o[2], vb, pa0, pa1, pa2, pa3); pv_one<3>(o[3], vb, pa0, pa1, pa2, pa3); __builtin_amdgcn_s_setprio(0); }
        if (jj + 2 < NT) asm volatile("s_waitcnt vmcnt(5) lgkmcnt(0)" ::: "memory"); else asm volatile("s_waitcnt vmcnt(0) lgkmcnt(0)" ::: "memory");
        __builtin_amdgcn_s_barrier(); asm volatile("" ::: "memory");
        kcur = kcur == 2 ? 0 : kcur + 1;
    }
    if (lim > 0) {
        int hi_e = hi, r32_e = r32; asm volatile("" : "+v"(hi_e), "+v"(r32_e));
        if (hi_e == 0) li_l[r32_e] = l_reg;
        asm volatile("s_waitcnt lgkmcnt(0)" ::: "memory");
        __attribute__((address_space(3))) bf16_t* OL = (__attribute__((address_space(3))) bf16_t*)(lds + OFF_V + wid * 8192);
#pragma unroll
        for (int r = 0; r < 16; ++r) { const int orow = crow(r, hi_e); const float rl = __builtin_amdgcn_rcpf(li_l[orow]);
#pragma unroll
            for (int d0 = 0; d0 < 4; ++d0) OL[orow * 128 + d0 * 32 + r32_e] = f2bf(o[d0][r] * rl); }
        asm volatile("s_waitcnt lgkmcnt(0)" ::: "memory");
        bf16_t* Ow = U.O + (size_t)(wid * 32) * D;
#pragma unroll
        for (int q = 0; q < 8; ++q) { const int s16 = q * 64 + r32_e + 32 * hi_e, orow = s16 >> 4, oc = (s16 & 15) * 8;
            *(bf16x8*)(Ow + (size_t)orow * D + oc) = *(const __attribute__((address_space(3))) bf16x8*)(OL + orow * 128 + oc); }
    }
#undef ATT_SLOAD
#undef ATT_SWRITE
#undef ATT_KNORM
#undef ATT_DMA
}
__device__ __forceinline__ void acc_frags(const f32x16& p, bf16x8& f0, bf16x8& f1) {
#define ATT_PK4(P, BASE, OUT) do { unsigned a0 = cvtpk(P[BASE + 0], P[BASE + 1]), a1 = cvtpk(P[BASE + 2], P[BASE + 3]);   \
    unsigned b0 = cvtpk(P[BASE + 4], P[BASE + 5]), b1 = cvtpk(P[BASE + 6], P[BASE + 7]);                              \
    auto r0 = __builtin_amdgcn_permlane32_swap(a0, b0, false, false); auto r1 = __builtin_amdgcn_permlane32_swap(a1, b1, false, false); \
    u32x4 w = {r0[0], r1[0], r0[1], r1[1]}; OUT = __builtin_bit_cast(bf16x8, w); } while (0)
    ATT_PK4(p, 0, f0); ATT_PK4(p, 8, f1);
#undef ATT_PK4
}
__device__ __forceinline__ void run_sample_unit(const Unit& U_, lds_t* lds, int vhalf) {
    Unit U;
    U.Q = uni_ptr(U_.Q); U.O = uni_ptr(U_.O); U.K0 = uni_ptr(U_.K0); U.V0 = uni_ptr(U_.V0); U.KR0 = uni_ptr(U_.KR0); U.K1 = uni_ptr(U_.K1); U.V1 = uni_ptr(U_.V1); U.KR1 = uni_ptr(U_.KR1);
    U.n0 = uni_int(U_.n0); U.n1 = uni_int(U_.n1); U.jm = uni_int(U_.jm); U.nv = uni_int(U_.nv); U.pos0 = uni_int(U_.pos0);
    U.gqn = opq_ptr(U_.gqn); U.gqr = opq_ptr(U_.gqr); U.gkn = opq_ptr(U_.gkn); U.rtab = opq_ptr(U_.rtab); U.IK0 = uni_ptr(U_.IK0); U.WB = uni_ptr(U_.WB); U.IK1 = uni_ptr(U_.IK1); U.cnt = uni_ptr(U_.cnt); U.WV = uni_ptr(U_.WV); U.O2 = uni_ptr(U_.O2);
    int tid_ = my_tid(); asm volatile("" : "+v"(tid_));
    const int tid = tid_, wid = __builtin_amdgcn_readfirstlane(tid >> 6), lane = tid & 63, r32 = lane & 31, hi = lane >> 5;
    const int NT = U.n0 + U.n1;
    constexpr float C = ATTN_SCALE * 1.4426950408889634f;
    lds_t* myV = lds + wid * 16384;
    __attribute__((address_space(3))) float* al_l = (__attribute__((address_space(3))) float*)(lds + 131072 + wid * 256);
    __attribute__((address_space(3))) float* ML = (__attribute__((address_space(3))) float*)(lds + 131072 + NWV * 256);
    __attribute__((address_space(3))) float* iks = (__attribute__((address_space(3))) float*)(lds + 131072 + 4096 + wid * 512);
    lds_t* QL = lds + 131072 + 9216;
    const unsigned vb = (unsigned)(uintptr_t)myV + (unsigned)v_rd_base(lane);
    float m_reg = -1e30f, l_reg = 0.f; f32x16 o[4] = {};
    {
        bf16x8 qn[12];
        load_q(U, U.Q + (size_t)r32 * (NH * QKD) + hi * 8, U.pos0 + r32, hi, qn);
        const bf16_t* wb = U.WB + (size_t)(wid * 32 + r32) * 2048 + hi * 8;
        f32x16 a = {};
#pragma unroll
        for (int s = 0; s < 8; ++s) a = __builtin_amdgcn_mfma_f32_32x32x16_bf16(*(const bf16x8*)(wb + s * 16), qn[s], a, 0, 0, 0);
        asm volatile("s_nop 15\n\ts_nop 7" : "+v"(a));
        bf16x8 f0, f1; acc_frags(a, f0, f1);
        __syncthreads();
        *(__attribute__((address_space(3))) bf16x8*)(QL + (2 * wid) * 1024 + lane * 16) = f0; *(__attribute__((address_space(3))) bf16x8*)(QL + (2 * wid + 1) * 1024 + lane * 16) = f1;
        if (wid < 4) *(__attribute__((address_space(3))) bf16x8*)(QL + (16 + wid) * 1024 + lane * 16) = wid == 0 ? qn[8] : wid == 1 ? qn[9] : wid == 2 ? qn[10] : qn[11];
    }
    __syncthreads();
    const unsigned gvb = (unsigned)(((((lane & 31) >> 2) & 3) + ((((lane & 31) >> 4) & 1) << 3)) * KVL + hi * 32 + (lane & 3) * 8) + (unsigned)(vhalf * 128);
    const __attribute__((address_space(3))) bf16x8* qf = (const __attribute__((address_space(3))) bf16x8*)(QL + lane * 16);
    for (int j = wid; j < NT; j += NWV) {
        const bool s0 = j < U.n0; const size_t ro = (size_t)(s0 ? j : j - U.n0) * 64;
        const bf16_t* Cb = (s0 ? U.V0 : U.V1) + ro * KVL; const bf16_t* Rt = (s0 ? U.KR0 : U.KR1) + ro * ROPE;
        const int kst = s0 ? 1024 : 16;
        const bf16_t* kb0 = s0 ? U.K0 + ro * 256 : Cb; const bf16_t* kb1 = s0 ? kb0 + 512 : kb0 + (size_t)32 * KVL; const unsigned ko = s0 ? (unsigned)(hi * 256 + r32 * 8) : (unsigned)(r32 * KVL + hi * 8);
        const bf16_t* rb0 = Rt; const bf16_t* rb1 = s0 ? Rt + 512 : Rt + (size_t)32 * ROPE; const unsigned rof = s0 ? (unsigned)(hi * 256 + r32 * 8) : (unsigned)(r32 * ROPE + hi * 8);
        float rs0, rs1;
        if (s0) { rs0 = U.IK0[ro + r32]; rs1 = U.IK0[ro + 32 + r32]; }
        else { const float* t0 = U.IK1 + (size_t)(ro + r32) * 16; const float a0 = t0[0] + t0[1], a1 = t0[32 * 16] + t0[32 * 16 + 1];
            rs0 = rsqrtf(a0 * (1.f / NOPE) + EPS); rs1 = rsqrtf(a1 * (1.f / NOPE) + EPS); }
        bf16x8 xr0[4], xr1[4], xa0[8], xa1[8];
#pragma unroll
        for (int d0 = 0; d0 < 4; ++d0) { xr0[d0] = *(const bf16x8*)(rb0 + d0 * kst + rof); xr1[d0] = *(const bf16x8*)(rb1 + d0 * kst + rof); }
#pragma unroll
        for (int d0 = 0; d0 < 8; ++d0) { xa0[d0] = *(const bf16x8*)(kb0 + d0 * kst + ko); xa1[d0] = *(const bf16x8*)(kb1 + d0 * kst + ko); }
#pragma unroll
        for (int i = 0; i < 16; ++i)
            __builtin_amdgcn_global_load_lds((const unsigned*)(Cb + gvb + (16 * (i >> 2) + 4 * ((i >> 1) & 1)) * KVL + (i & 1) * 64), (__attribute__((address_space(3))) unsigned*)(myV + i * 1024), 16, 0, 0);
        ATT_SBAR();
        if (hi == 0) { iks[r32] = rs0; iks[32 + r32] = rs1; iks[64 + r32] = __builtin_amdgcn_rcpf(rs0); iks[96 + r32] = __builtin_amdgcn_rcpf(rs1); }
        f32x16 p0 = {}, p1 = {};
#pragma unroll
        for (int d0 = 0; d0 < 4; ++d0) { const bf16x8 q = qf[(16 + d0) * 64]; p0 = __builtin_amdgcn_mfma_f32_32x32x16_bf16(xr0[d0], q, p0, 0, 0, 0); p1 = __builtin_amdgcn_mfma_f32_32x32x16_bf16(xr1[d0], q, p1, 0, 0, 0); }
        ATT_SBAR();
        bf16x8 xb0[4], xb1[4];
#pragma unroll
        for (int d0 = 0; d0 < 4; ++d0) { xb0[d0] = *(const bf16x8*)(kb0 + (8 + d0) * kst + ko); xb1[d0] = *(const bf16x8*)(kb1 + (8 + d0) * kst + ko); }
        ATT_SBAR();
#pragma unroll
        for (int g = 0; g < 4; ++g) { const f32x4 i0 = *(const __attribute__((address_space(3))) f32x4*)(iks + 64 + 8 * g + 4 * hi), i1 = *(const __attribute__((address_space(3))) f32x4*)(iks + 96 + 8 * g + 4 * hi);
#pragma unroll
            for (int i = 0; i < 4; ++i) { p0[4 * g + i] *= i0[i]; p1[4 * g + i] *= i1[i]; } }
#pragma unroll
        for (int d0 = 0; d0 < 4; ++d0) { const bf16x8 q = qf[d0 * 64]; p0 = __builtin_amdgcn_mfma_f32_32x32x16_bf16(xa0[d0], q, p0, 0, 0, 0); p1 = __builtin_amdgcn_mfma_f32_32x32x16_bf16(xa1[d0], q, p1, 0, 0, 0); }
        ATT_SBAR();
        bf16x8 xc0[4], xc1[4];
#pragma unroll
        for (int d0 = 0; d0 < 4; ++d0) { xc0[d0] = *(const bf16x8*)(kb0 + (12 + d0) * kst + ko); xc1[d0] = *(const bf16x8*)(kb1 + (12 + d0) * kst + ko); }
        ATT_SBAR();
#pragma unroll
        for (int d0 = 4; d0 < 8; ++d0) { const bf16x8 q = qf[d0 * 64]; p0 = __builtin_amdgcn_mfma_f32_32x32x16_bf16(xa0[d0], q, p0, 0, 0, 0); p1 = __builtin_amdgcn_mfma_f32_32x32x16_bf16(xa1[d0], q, p1, 0, 0, 0); }
#pragma unroll
        for (int d0 = 0; d0 < 4; ++d0) { const bf16x8 q = qf[(8 + d0) * 64]; p0 = __builtin_amdgcn_mfma_f32_32x32x16_bf16(xb0[d0], q, p0, 0, 0, 0); p1 = __builtin_amdgcn_mfma_f32_32x32x16_bf16(xb1[d0], q, p1, 0, 0, 0); }
#pragma unroll
        for (int d0 = 0; d0 < 4; ++d0) { const bf16x8 q = qf[(12 + d0) * 64]; p0 = __builtin_amdgcn_mfma_f32_32x32x16_bf16(xc0[d0], q, p0, 0, 0, 0); p1 = __builtin_amdgcn_mfma_f32_32x32x16_bf16(xc1[d0], q, p1, 0, 0, 0); }
#pragma unroll
        for (int g = 0; g < 4; ++g) { const f32x4 i0 = *(const __attribute__((address_space(3))) f32x4*)(iks + 8 * g + 4 * hi), i1 = *(const __attribute__((address_space(3))) f32x4*)(iks + 32 + 8 * g + 4 * hi);
#pragma unroll
            for (int i = 0; i < 4; ++i) { p0[4 * g + i] *= i0[i]; p1[4 * g + i] *= i1[i]; } }
        if (j == U.jm) { const int kb = 4 * hi;
#pragma unroll
            for (int r = 0; r < 16; ++r) { const int kv = kb + (r & 3) + 8 * (r >> 2); if (kv >= U.nv) p0[r] = -INFINITY; if (kv + 32 >= U.nv) p1[r] = -INFINITY; } }
        float alpha; bf16x8 pa0, pa1, pa2, pa3;
        partialSM(p0, p1, m_reg, alpha);
        if (__any(alpha < 1.f)) {
            if (hi == 0) al_l[r32] = alpha;
            asm volatile("s_waitcnt lgkmcnt(0)" ::: "memory");
#pragma unroll
            for (int r = 0; r < 16; ++r) { const float a = al_l[crow(r, hi)];
#pragma unroll
                for (int d = 0; d < 4; ++d) o[d][r] *= a; }
        }
        finishSM(p0, p1, alpha, l_reg, pa0, pa1, pa2, pa3);
        asm volatile("s_waitcnt vmcnt(0) lgkmcnt(0)" ::: "memory");
        pv_one<0>(o[0], vb, pa0, pa1, pa2, pa3); pv_one<1>(o[1], vb, pa0, pa1, pa2, pa3); pv_one<2>(o[2], vb, pa0, pa1, pa2, pa3); pv_one<3>(o[3], vb, pa0, pa1, pa2, pa3);
    }
    {
        int hi_e = hi, r32_e = r32; asm volatile("" : "+v"(hi_e), "+v"(r32_e));
        __attribute__((address_space(3))) float* OP = (__attribute__((address_space(3))) float*)myV;
        asm volatile("s_waitcnt lgkmcnt(0)" ::: "memory");
#pragma unroll
        for (int r = 0; r < 16; ++r)
#pragma unroll
            for (int d0 = 0; d0 < 4; ++d0) OP[crow(r, hi_e) * 128 + d0 * 32 + r32_e] = o[d0][r];
        if (hi_e == 0) { ML[(wid * 32 + r32_e) * 2] = m_reg; ML[(wid * 32 + r32_e) * 2 + 1] = l_reg; }
    }
    __syncthreads();
    {
        const int row = tid >> 4, c0 = (tid & 15) * 8;
        float M = -1e30f;
#pragma unroll
        for (int w = 0; w < NWV; ++w) M = fmaxf(M, ML[(w * 32 + row) * 2]);
        float L = 0.f; float acc[8] = {0.f, 0.f, 0.f, 0.f, 0.f, 0.f, 0.f, 0.f};
#pragma unroll
        for (int w = 0; w < NWV; ++w) { const float wg = __builtin_amdgcn_exp2f((ML[(w * 32 + row) * 2] - M) * C); L += wg * ML[(w * 32 + row) * 2 + 1];
            const __attribute__((address_space(3))) float* op = (const __attribute__((address_space(3))) float*)(lds + w * 16384) + row * 128 + c0;
            const f32x4 a = *(const __attribute__((address_space(3))) f32x4*)op, b = *(const __attribute__((address_space(3))) f32x4*)(op + 4);
            acc[0] += wg * a[0]; acc[1] += wg * a[1]; acc[2] += wg * a[2]; acc[3] += wg * a[3]; acc[4] += wg * b[0]; acc[5] += wg * b[1]; acc[6] += wg * b[2]; acc[7] += wg * b[3]; }
        const float il = 1.f / L;
        u32x4 w; w.x = cvtpk(acc[0] * il, acc[1] * il); w.y = cvtpk(acc[2] * il, acc[3] * il); w.z = cvtpk(acc[4] * il, acc[5] * il); w.w = cvtpk(acc[6] * il, acc[7] * il);
        *(u32x4*)(U.O + (size_t)row * 2048 + vhalf * 128 + c0) = w;
    }
    {
        __attribute__((address_space(3))) unsigned* tk = (__attribute__((address_space(3))) unsigned*)(lds + 131072 + 8192);
        asm volatile("s_waitcnt vmcnt(0)" ::: "memory");
        __syncthreads();
        if (tid == 0) { __builtin_amdgcn_fence(__ATOMIC_RELEASE, "agent"); asm volatile("s_waitcnt vmcnt(0)" ::: "memory");
                        *tk = __hip_atomic_fetch_add(U.cnt, 1u, __ATOMIC_RELAXED, __HIP_MEMORY_SCOPE_AGENT); }
        __syncthreads();
        const unsigned ticket = *tk;
        if (ticket == 1u && wid < 4) {
            __builtin_amdgcn_fence(__ATOMIC_ACQUIRE, "agent");
            int hi_e = hi, r32_e = r32; asm volatile("" : "+v"(hi_e), "+v"(r32_e));
            const bf16_t* wv = U.WV + (size_t)(32 * wid + r32_e) * KVL + hi_e * 8; const bf16_t* ol = U.O + (size_t)r32_e * 2048 + hi_e * 8;
            f32x16 acc = {};
#pragma unroll
            for (int s = 0; s < 16; ++s) acc = __builtin_amdgcn_mfma_f32_32x32x16_bf16(*(const bf16x8*)(wv + s * 16), *(const bf16x8*)(ol + s * 16), acc, 0, 0, 0);
            asm volatile("s_nop 15\n\ts_nop 7" : "+v"(acc));
            bf16_t* op = U.O2 + (size_t)r32_e * D + 32 * wid + 4 * hi_e;
#pragma unroll
            for (int g = 0; g < 4; ++g) { uint2 w2; w2.x = cvtpk(acc[4 * g], acc[4 * g + 1]); w2.y = cvtpk(acc[4 * g + 2], acc[4 * g + 3]); *(uint2*)(op + 8 * g) = w2; }
        }
    }
}
}

typedef unsigned u32x4_t __attribute__((ext_vector_type(4)));
typedef float f32x2_t __attribute__((ext_vector_type(2)));
__device__ __forceinline__ u32x4_t pack8(const f32x4 a, const f32x4 b) { u32x4_t w; w.x = pg8::cvt_pk_bf16(a[0], a[1]); w.y = pg8::cvt_pk_bf16(a[2], a[3]); w.z = pg8::cvt_pk_bf16(b[0], b[1]); w.w = pg8::cvt_pk_bf16(b[2], b[3]); return w; }
__device__ __forceinline__ void unpack8(const u32x4_t w, f32x4& a, f32x4& b) {
    a[0] = __uint_as_float(w.x << 16); a[1] = __uint_as_float(w.x & 0xffff0000u); a[2] = __uint_as_float(w.y << 16); a[3] = __uint_as_float(w.y & 0xffff0000u);
    b[0] = __uint_as_float(w.z << 16); b[1] = __uint_as_float(w.z & 0xffff0000u); b[2] = __uint_as_float(w.w << 16); b[3] = __uint_as_float(w.w & 0xffff0000u); }
__device__ __forceinline__ float rowsum4(float v) {
    { auto a = __builtin_amdgcn_permlane16_swap(__float_as_uint(v), __float_as_uint(v), false, false); v = __uint_as_float(a[0]) + __uint_as_float(a[1]); }
    { auto b = __builtin_amdgcn_permlane32_swap(__float_as_uint(v), __float_as_uint(v), false, false); v = __uint_as_float(b[0]) + __uint_as_float(b[1]); }
    return v; }
__device__ __forceinline__ f32x4 sig4(const f32x4 x) { f32x4 r; r[0] = sigmoidf_(x[0]); r[1] = sigmoidf_(x[1]); r[2] = sigmoidf_(x[2]); r[3] = sigmoidf_(x[3]); return r; }
#define LAS __attribute__((address_space(3)))
#define XB_TMO      128
#define XB_XCNT(j)  (256  + 64 * (j))
#define XB_XSUB(j)  (1280 + 64 * (j))
#define XB_XGEN(j)  (2304 + 64 * (j))
#define XB_TOP      3328
#define XB_TOPGEN   3392
#define XCD_BAR_WORDS 3456
#define XB_SPIN_CAP (1u << 18)

__device__ __forceinline__ unsigned xb_ld(unsigned* p)              { return __hip_atomic_load(p, __ATOMIC_RELAXED, __HIP_MEMORY_SCOPE_AGENT); }
__device__ __forceinline__ unsigned xb_add(unsigned* p, unsigned v) { return __hip_atomic_fetch_add(p, v, __ATOMIC_RELAXED, __HIP_MEMORY_SCOPE_AGENT); }
__device__ __forceinline__ unsigned xb_xcc_id() { return (unsigned)__builtin_amdgcn_s_getreg((3 << 11) | 20) & 0xFu; }
#define XB_SPIN(cond, bar) do { unsigned _sp = 0; while (cond) { __builtin_amdgcn_s_sleep(1); \
    if ((++_sp & 255u) == 0u) { if (xb_ld(&(bar)[XB_TMO])) break; if (_sp > XB_SPIN_CAP) { atomicAdd(&(bar)[XB_TMO], 1u); break; } } } } while (0)

struct XcdBarrier {
    unsigned* bar; unsigned x;
    volatile LAS unsigned* st;
};

__device__ __forceinline__ XcdBarrier xcd_barrier_post(unsigned* bar, volatile LAS unsigned* st) {
    XcdBarrier b; b.bar = bar; b.x = xb_xcc_id(); b.st = st;
    if (my_tid() == 0) (void)xb_add(&bar[XB_XCNT(b.x)], 1u);
    return b;
}
__device__ __forceinline__ void xcd_barrier_complete(unsigned* bar, unsigned x, unsigned& nloc, unsigned& nx) {
    const unsigned G = gridDim.x * gridDim.y * gridDim.z;
    unsigned sum, cnt, mine, sp = 0u;
    for (;;) {
        sum = 0u; cnt = 0u; mine = 0u;
#pragma unroll
        for (unsigned j = 0; j < 16; ++j) { const unsigned c = xb_ld(&bar[XB_XCNT(j)]); sum += c; cnt += (c > 0u) ? 1u : 0u; mine = (j == x) ? c : mine; }
        if (sum == G) break;
        __builtin_amdgcn_s_sleep(1);
        if ((++sp & 255u) == 0u) { if (xb_ld(&bar[XB_TMO])) break; if (sp > XB_SPIN_CAP) { atomicAdd(&bar[XB_TMO], 1u); break; } }
    }
    nloc = mine > 0u ? mine : 1u; nx = cnt > 0u ? cnt : 1u;
}

__device__ __noinline__ void xcd_barrier_impl(unsigned* bar, unsigned bx, volatile LAS unsigned* bst, bool leader);
__device__ __forceinline__ void xcd_barrier(const XcdBarrier& b) { int t_ = my_tid(); asm volatile("" : "+v"(t_)); xcd_barrier_impl(b.bar, b.x, b.st, t_ == 0); }
__device__ __noinline__ void xcd_barrier_impl(unsigned* bar_, unsigned bx_, volatile LAS unsigned* bst_, bool leader) {
    XcdBarrier b; b.bar = bar_; b.x = bx_; b.st = bst_;
    asm volatile("s_waitcnt vmcnt(0)" ::: "memory");
    __syncthreads();
    if (leader) {
        unsigned* bar = b.bar;
        __builtin_amdgcn_s_waitcnt(0);
        unsigned nloc = b.st[0], nx = b.st[1];
        if (nloc == 0u) { xcd_barrier_complete(bar, b.x, nloc, nx); b.st[0] = nloc; b.st[1] = nx; }
        const unsigned old = xb_add(&bar[XB_XSUB(b.x)], 1u);
        const unsigned gen = old / nloc;
        if (old + 1u == (gen + 1u) * nloc) {
            __builtin_amdgcn_fence(__ATOMIC_RELEASE, "agent");
            asm volatile("s_waitcnt vmcnt(0)" ::: "memory");
            const unsigned og = xb_add(&bar[XB_TOP], 1u);
            const unsigned tg = og / nx;
            if (og + 1u == (tg + 1u) * nx) xb_add(&bar[XB_TOPGEN], 1u);
            else XB_SPIN(xb_ld(&bar[XB_TOPGEN]) == tg, bar);
            __builtin_amdgcn_fence(__ATOMIC_ACQUIRE, "agent");
            xb_add(&bar[XB_XGEN(b.x)], 1u);
            asm volatile("s_waitcnt vmcnt(0)" ::: "memory");
        } else {
            XB_SPIN(xb_ld(&bar[XB_XGEN(b.x)]) == gen, bar);
            __builtin_amdgcn_fence(__ATOMIC_ACQUIRE, "agent");
            asm volatile("s_waitcnt vmcnt(0)" ::: "memory");
        }
    }
    __syncthreads();
}

struct Ctx { int tid, lane, wave, gw, ngw; size_t gt, ngt; unsigned char* lds; };

__device__ __forceinline__ void ph_rope_table(const Ctx& c, float* __restrict__ tab) {
    for (size_t ii = c.gt; ii < (size_t)LP * 32; ii += c.ngt) {
        const int i = (int)ii, p = i >> 5, f = i & 31;
        const double inv = exp2(-(double)f * (13.287712379549449 / 32.0));
        const double ang = (double)(p - NMETA) * inv;
        const double rev = ang * 0.15915494309189535;
        const double fr = rev - rint(rev);
        const float a = (float)(fr * 6.283185307179586);
        tab[2 * i] = cosf(a); tab[2 * i + 1] = sinf(a);
    }
}
__device__ __forceinline__ size_t cf_off(size_t i) { const size_t rw = i >> 5; const unsigned cc = (unsigned)(i & 31), key = (unsigned)(rw & 63); return (rw >> 6) * 16384 + (size_t)(((((cc >> 1) * 2 + (key >> 5)) * 2 + (cc & 1)) * 32 + (key & 31)) * 8); }
__device__ __forceinline__ void ph_cache_prep(const Ctx& cx, const Params& P, int part) {
    bf16_t* CALL = (bf16_t*)(P.ws + WS_CALL); bf16_t* KR = (bf16_t*)(P.ws + WS_KR); bf16_t* CF = (bf16_t*)(P.ws + WS_CF);
    const float* clat = P.in[2]; const float* ckr = P.in[3]; const float* mlat = P.in[4]; const float* mkr = P.in[5];
    const size_t gsz = cx.ngt, g0 = cx.gt;
    if (part == 1) {
        constexpr size_t NL = (size_t)DB * PAST * KVL / 8, NR = (size_t)DB * PAST * ROPE / 8;
        constexpr int QL_ = 11, QR_ = 3;
        f32x4 ra[QR_], rb_[QR_];
#pragma unroll
        for (int q = 0; q < QR_; ++q) if (g0 + q * gsz < NR) { ra[q] = *(const f32x4*)(ckr + (g0 + q * gsz) * 8); rb_[q] = *(const f32x4*)(ckr + (g0 + q * gsz) * 8 + 4); }
        { f32x4 a[QL_], b[QL_];
#pragma unroll
          for (int q = 0; q < QL_; ++q) if (g0 + q * gsz < NL) { a[q] = *(const f32x4*)(clat + (g0 + q * gsz) * 8); b[q] = *(const f32x4*)(clat + (g0 + q * gsz) * 8 + 4); }
#pragma unroll
          for (int q = 0; q < QL_; ++q) if (g0 + q * gsz < NL) { const u32x4_t w = pack8(a[q], b[q]); const size_t ii = g0 + q * gsz; *(u32x4_t*)(CALL + (size_t)KV_SC0 * KVL + ii * 8) = w; *(u32x4_t*)(CF + cf_off(ii)) = w; } }
        for (size_t i = g0 + QL_ * gsz; i < NL; i += gsz) { const f32x4 a = *(const f32x4*)(clat + i * 8), b = *(const f32x4*)(clat + i * 8 + 4); const u32x4_t w = pack8(a, b); *(u32x4_t*)(CALL + (size_t)KV_SC0 * KVL + i * 8) = w; *(u32x4_t*)(CF + cf_off(i)) = w; }
#define KR_STORE(ii_, a_, b_) do { const size_t rw = (ii_) >> 3; const int c16 = (int)((ii_) & 7), key = (int)(rw & 63); const size_t tl = rw >> 6; \
            *(u32x4_t*)(KR + (size_t)KV_SC0 * ROPE + tl * 4096 + ((((c16 >> 1) * 2 + (key >> 5)) * 2 + (c16 & 1)) * 32 + (key & 31)) * 8) = pack8(a_, b_); } while (0)
#pragma unroll
        for (int q = 0; q < QR_; ++q) if (g0 + q * gsz < NR) KR_STORE(g0 + q * gsz, ra[q], rb_[q]);
        for (size_t ir = g0 + QR_ * gsz; ir < NR; ir += gsz) { const f32x4 a = *(const f32x4*)(ckr + ir * 8), b = *(const f32x4*)(ckr + ir * 8 + 4); KR_STORE(ir, a, b); }
#undef KR_STORE
    }
    if (part == 1) return;
    for (size_t i = g0; i < (size_t)KVT * KVL / 8; i += gsz) {
        const int tr = (int)(i >> 5), c = (int)(i & 31) * 8, slot = tr >> 6, j = tr & 63; u32x4_t w = {0u, 0u, 0u, 0u}; bool st = false;
        if (slot < NB) st = j >= NMETA;
        else if (j >= 48) st = true;
        else if (j >= 32) { const float* s = mlat + ((size_t)(slot - NB) * NMETA + (j - 32)) * KVL + c; w = pack8(*(const f32x4*)s, *(const f32x4*)(s + 4)); st = true; }
        if (st) *(u32x4_t*)(CALL + (size_t)(KV_T0 + tr) * KVL + c) = w;
    }
    for (size_t i = g0; i < (size_t)KVT * ROPE / 8; i += gsz) {
        const int tr = (int)(i >> 3), c = (int)(i & 7) * 8, slot = tr >> 6, j = tr & 63; u32x4_t w = {0u, 0u, 0u, 0u}; bool st = false;
        if (slot < NB) st = j >= NMETA;
        else if (j >= 48) st = true;
        else if (j >= 32) { const float* s = mkr + ((size_t)(slot - NB) * NMETA + (j - 32)) * ROPE + c; w = pack8(*(const f32x4*)s, *(const f32x4*)(s + 4)); st = true; }
        if (st) *(u32x4_t*)(KR + (size_t)(KV_T0 + tr) * ROPE + c) = w;
    }
}
__device__ __forceinline__ const float* x_row(const Params& P, int r) {
    if (r < TM) return P.in[0] + (size_t)r * D;
    if (r < TMETA0) return P.in[1] + (size_t)(r - TS0) * D;
    return P.in[8] + (size_t)((r - TMETA0) & (NMETA - 1)) * D;
}
__device__ __forceinline__ void ph_xn(const Ctx& c, const Params& P) {
    bf16_t* XN = (bf16_t*)(P.ws + WS_E);
    const int l = c.lane & 15, grp = c.lane >> 4;
    for (int r = c.gw * 4 + grp; r < T; r += c.ngw * 4) {
        const float* x = x_row(P, r);
        f32x4 v[16]; float ss = 0.f;
#pragma unroll
        for (int j = 0; j < 16; ++j) { v[j] = *(const f32x4*)(x + j * 64 + l * 4); ss += (v[j][0] * v[j][0] + v[j][1] * v[j][1]) + (v[j][2] * v[j][2] + v[j][3] * v[j][3]); }
        ss += __shfl_xor(ss, 1); ss += __shfl_xor(ss, 2); ss += __shfl_xor(ss, 4); ss += __shfl_xor(ss, 8);
        const float rs = rsqrtf(ss * (1.f / D) + EPS);
#pragma unroll
        for (int j = 0; j < 16; ++j) { const f32x4 y = v[j] * rs * *(const f32x4*)(P.in[9] + j * 64 + l * 4);
            typedef unsigned u32x2_t __attribute__((ext_vector_type(2))); u32x2_t w; w.x = pg8::cvt_pk_bf16(y[0], y[1]); w.y = pg8::cvt_pk_bf16(y[2], y[3]);
            *(u32x2_t*)(XN + (size_t)r * D + j * 64 + l * 4) = w; }
    }
}
struct EpiG1 {
    static constexpr bool DUAL = false, ROWSSQ = false;
    bf16_t *zq, *U, *GA, *GB;
    __device__ int brow(int j) const { return j; } __device__ int brow2(int j) const { return j; }
    __device__ void operator()(int r, int n, float acc, float) const {
        if (n < O_SSM) zq[(size_t)r * O_SSM + n] = f2bf(acc);
        else if (n < O_GA) { const int ch = n - O_SSM, g = ch >> 4, c = ch & 15; size_t idx;
            if (r < TM) { const int b = r >> 12, t = r & (SEQ - 1); idx = ((size_t)(b * NG + g) * LP + NMETA + t) * GS + c; }
            else if (r < TMETA0) { const int s = r - TS0, b = s >> 5, t = s & 31; idx = (size_t)NB * NG * LP * GS + ((size_t)(b * NG + g) * DS + t) * GS + c; }
            else { const int s = r - TMETA0, b = s >> 4, mm = s & 15; idx = ((size_t)(b * NG + g) * LP + mm) * GS + c; }
            U[idx] = f2bf(acc); }
        else if (n < O_GB) GA[(size_t)r * D + (n - O_GA)] = f2bf(sigmoidf_(acc));
        else if (n < INC) GB[(size_t)r * D + (n - O_GB)] = f2bf(sigmoidf_(acc));
    }
    __device__ void rowstat(int, int, float) const {}
};
struct EpiQ {
    static constexpr bool DUAL = false, ROWSSQ = false;
    bf16_t *Qm, *Qt;
    __device__ int brow(int j) const { return j; } __device__ int brow2(int j) const { return j; }
    __device__ void operator()(int r, int n, float acc, float) const { if (r < TM) Qm[(size_t)r * (NH * QKD) + n] = f2bf(acc); else Qt[(size_t)(r - TM) * (NH * QKD) + n] = f2bf(acc); }
    __device__ void rowstat(int, int, float) const {}
};
typedef unsigned u32x2v __attribute__((ext_vector_type(2)));
__device__ __forceinline__ u32x2v pack4(const f32x4 a) { u32x2v w; w.x = pg8::cvt_pk_bf16(a[0], a[1]); w.y = pg8::cvt_pk_bf16(a[2], a[3]); return w; }
__device__ __forceinline__ f32x4 unpack4(const u32x2v w) { f32x4 a; a[0] = __uint_as_float(w.x << 16); a[1] = __uint_as_float(w.x & 0xffff0000u); a[2] = __uint_as_float(w.y << 16); a[3] = __uint_as_float(w.y & 0xffff0000u); return a; }
struct EpiKV {
    static constexpr bool DUAL = false, ROWSSQ = false;
    bf16_t *Kd, *Vd;
    __device__ int brow(int j) const { return j; } __device__ int brow2(int j) const { return j; }
    __device__ void operator()(int r, int n, float acc, float) const { const int h = n >> 8, d = n & 255; if (d < NOPE) Kd[(size_t)r * D + h * NOPE + d] = f2bf(acc); else Vd[(size_t)r * D + h * VD + (d - NOPE)] = f2bf(acc); }
    struct Pre {}; __device__ Pre pre(int, int) const { return Pre{}; }
    __device__ float vec4(int r, int n, const f32x4 v, const f32x4, const Pre&) const { const int h = n >> 8, d = n & 255; bf16_t* p = d < NOPE ? Kd + (size_t)r * D + h * NOPE + d : Vd + (size_t)r * D + h * VD + (d - NOPE); *(u32x2v*)p = pack4(v); return 0.f; }
    __device__ void rowstat(int, int, float) const {}
};
struct EpiKss {
    static constexpr bool DUAL = false, ROWSSQ = true;
    float* S;
    __device__ int brow(int j) const { return j; } __device__ int brow2(int j) const { return j; }
    __device__ float operator()(int, int, float acc, float) const { return acc * acc; }
    struct Pre {}; __device__ Pre pre(int, int) const { return Pre{}; }
    __device__ float vec4(int, int, const f32x4 v, const f32x4, const Pre&) const { return (v[0] * v[0] + v[1] * v[1]) + (v[2] * v[2] + v[3] * v[3]); }
    __device__ void rowstat(int r, int tn, float s) const { S[(size_t)r * 16 + tn] = s; }
};
struct EpiGlu {
    static constexpr bool DUAL = true, ROWSSQ = false;
    bf16_t* GB;
    __device__ int brow(int j) const { return (j >> 7) * 256 + (j & 127); } __device__ int brow2(int j) const { return (j >> 7) * 256 + 128 + (j & 127); }
    __device__ void operator()(int r, int j, float v, float g) const { bf16_t* p = GB + (size_t)r * D + j; *p = f2bf(bf2f(*p) * v * sigmoidf_(g)); }
    struct Pre { u32x2v gb; }; __device__ Pre pre(int r, int j) const { return Pre{*(const u32x2v*)(GB + (size_t)r * D + j)}; }
    __device__ float vec4(int r, int j, const f32x4 v, const f32x4 g, const Pre& p) const { *(u32x2v*)(GB + (size_t)r * D + j) = pack4(unpack4(p.gb) * v * sig4(g)); return 0.f; }
    __device__ void rowstat(int, int, float) const {}
};
struct EpiMerge {
    static constexpr bool DUAL = false, ROWSSQ = false;
    bf16_t* GA; const bf16_t* OB; int roff;
    __device__ int brow(int j) const { return j; } __device__ int brow2(int j) const { return j; }
    __device__ void operator()(int r, int j, float acc, float) const { bf16_t* p = GA + (size_t)(roff + r) * D + j; *p = f2bf(bf2f(*p) * acc + bf2f(OB[(size_t)(roff + r) * D + j])); }
    struct Pre { u32x2v ga, ob; }; __device__ Pre pre(int r, int j) const { return Pre{*(const u32x2v*)(GA + (size_t)(roff + r) * D + j), *(const u32x2v*)(OB + (size_t)(roff + r) * D + j)}; }
    __device__ float vec4(int r, int j, const f32x4 v, const f32x4, const Pre& p) const { *(u32x2v*)(GA + (size_t)(roff + r) * D + j) = pack4(unpack4(p.ga) * v + unpack4(p.ob)); return 0.f; }
    __device__ void rowstat(int, int, float) const {}
};
struct EpiWp {
    static constexpr bool DUAL = false, ROWSSQ = false;
    bf16_t* Wp;
    __device__ int brow(int j) const { return j; } __device__ int brow2(int j) const { return j; }
    __device__ void operator()(int r, int j, float acc, float) const { Wp[(size_t)r * 2048 + j] = f2bf(acc); }
    __device__ void rowstat(int, int, float) const {}
};
struct EpiH1 {
    static constexpr bool DUAL = false, ROWSSQ = true;
    const float* xs; bf16_t* H1b; float* P2t;
    __device__ int brow(int j) const { return j; } __device__ int brow2(int j) const { return j; }
    __device__ float operator()(int r, int j, float acc, float) const { const float h = xs[(size_t)(r - TS0) * D + j] + acc; H1b[(size_t)r * D + j] = f2bf(h); return h * h; }
    struct Pre {}; __device__ Pre pre(int, int) const { return Pre{}; }
    __device__ float vec4(int r, int j, const f32x4 v, const f32x4, const Pre&) const { const f32x4 h = *(const f32x4*)(xs + (size_t)(r - TS0) * D + j) + v; *(u32x2v*)(H1b + (size_t)r * D + j) = pack4(h); return (h[0] * h[0] + h[1] * h[1]) + (h[2] * h[2] + h[3] * h[3]); }
    __device__ void rowstat(int r, int tn, float s) const { P2t[(size_t)(r - TS0) * 16 + tn] = s; }
};
struct EpiUp {
    static constexpr bool DUAL = false, ROWSSQ = false;
    bf16_t* A1t; const float* P2t;
    __device__ int brow(int j) const { return j; } __device__ int brow2(int j) const { return j; }
    __device__ float operator()(int r, int j, float acc, float) const {
        const f32x4* p = (const f32x4*)(P2t + (size_t)(r - TS0) * 16); const f32x4 a = p[0], b = p[1], c = p[2], d = p[3];
        const float ss = ((a[0] + a[1]) + (a[2] + a[3])) + ((b[0] + b[1]) + (b[2] + b[3])) + ((c[0] + c[1]) + (c[2] + c[3])) + ((d[0] + d[1]) + (d[2] + d[3]));
        const float rs2 = 1.f / (ss * (1.f / D) + EPS), t = fmaxf(acc, 0.f); A1t[(size_t)(r - TM) * DFF + j] = f2bf(t * t * rs2); return 0.f; }
    struct Pre {}; __device__ Pre pre(int, int) const { return Pre{}; }
    __device__ float vec4(int r, int j, const f32x4 v, const f32x4, const Pre&) const {
        const f32x4* p = (const f32x4*)(P2t + (size_t)(r - TS0) * 16); const f32x4 a = p[0], b = p[1], c = p[2], d = p[3];
        const float ss = ((a[0] + a[1]) + (a[2] + a[3])) + ((b[0] + b[1]) + (b[2] + b[3])) + ((c[0] + c[1]) + (c[2] + c[3])) + ((d[0] + d[1]) + (d[2] + d[3]));
        const float rs2 = 1.f / (ss * (1.f / D) + EPS); f32x4 t; t[0] = fmaxf(v[0], 0.f); t[1] = fmaxf(v[1], 0.f); t[2] = fmaxf(v[2], 0.f); t[3] = fmaxf(v[3], 0.f);
        *(u32x2v*)(A1t + (size_t)(r - TM) * DFF + j) = pack4(t * t * rs2); return 0.f; }
    __device__ void rowstat(int, int, float) const {}
};
struct EpiDown {
    static constexpr bool DUAL = false, ROWSSQ = false;
    const bf16_t* H1b; float* O;
    __device__ int brow(int j) const { return j; } __device__ int brow2(int j) const { return j; }
    __device__ float operator()(int r, int j, float acc, float) const { O[(size_t)r * D + j] = bf2f(H1b[(size_t)(TS0 + r) * D + j]) + acc; return 0.f; }
    struct Pre {}; __device__ Pre pre(int, int) const { return Pre{}; }
    __device__ float vec4(int r, int j, const f32x4 v, const f32x4, const Pre&) const { *(f32x4*)(O + (size_t)r * D + j) = unpack4(*(const u32x2v*)(H1b + (size_t)(TS0 + r) * D + j)) + v; return 0.f; }
    __device__ void rowstat(int, int, float) const {}
};

constexpr int TLD = 68;
template <class Epi, int MF = 4, int NB_ = 3>
__device__ __forceinline__ void ph_gemm_tail(unsigned char* lds_, const bf16_t* __restrict__ A, int lda, const bf16_t* __restrict__ Bt, int ldb, int M0, int M, int N, int K, Epi E, int bid = -1, int nb = 0) {
    if (bid < 0) { bid = blockIdx.x; nb = gridDim.x; }
    int tid_ = my_tid(); asm volatile("" : "+v"(tid_));
    const int tid = tid_, w = __builtin_amdgcn_readfirstlane(tid >> 6), lane = tid & 63, fr = lane & 15, fq = lane >> 4;
    typedef __attribute__((address_space(3))) float lds_f;
    lds_f* PL = (lds_f*)lds_;
    constexpr int NCOL = Epi::DUAL ? 32 : 64;
    const int ntm = (M - M0) / (16 * MF), ntn = N / NCOL, ntiles = ntm * ntn, nks = K >> 5;
    for (int tile = bid; tile < ntiles; tile += nb) {
        const int tm = tile % ntm, tn = tile / ntm, r0 = M0 + tm * (16 * MF), j0 = tn * NCOL;
        f32x4 acc[MF][4];
#pragma unroll
        for (int a = 0; a < MF; ++a)
#pragma unroll
            for (int b = 0; b < 4; ++b) acc[a][b] = (f32x4){0.f, 0.f, 0.f, 0.f};
        const bf16_t* Ar = A + (size_t)r0 * lda;
        unsigned ao[MF], bo[4];
#pragma unroll
        for (int mf = 0; mf < MF; ++mf) ao[mf] = (unsigned)((16 * mf + fr) * lda + 8 * fq);
#pragma unroll
        for (int nf = 0; nf < 4; ++nf) { const int jj = 16 * nf + fr; const int br = Epi::DUAL ? (jj < 32 ? E.brow(j0 + jj) : E.brow2(j0 + jj - 32)) : E.brow(j0 + jj); bo[nf] = (unsigned)(br * ldb + 8 * fq); }
        constexpr int NQ_ = Epi::DUAL ? 1 : MF / 2;
        typename Epi::Pre pre[NQ_];
        if (Epi::DUAL) { if (tid < 128 * MF) pre[0] = E.pre(r0 + (tid >> 3), j0 + (tid & 7) * 4); }
        else {
#pragma unroll
            for (int i = 0; i < NQ_; ++i) { const int o = tid + NTHR * i; pre[i] = E.pre(r0 + (o >> 4), j0 + (o & 15) * 4); } }
        for (int ks0 = w; ks0 < nks; ks0 += NB_ * NWV) {
            bf16x8 af[NB_][MF], bf[NB_][4];
#pragma unroll
            for (int q = 0; q < NB_; ++q) { const int ks = ks0 + q * NWV;
                if (ks < nks) {
#pragma unroll
                    for (int mf = 0; mf < MF; ++mf) af[q][mf] = *(const bf16x8*)(Ar + ao[mf] + 32 * ks);
#pragma unroll
                    for (int nf = 0; nf < 4; ++nf) bf[q][nf] = *(const bf16x8*)(Bt + bo[nf] + 32 * ks);
                } }
#pragma unroll
            for (int q = 0; q < NB_; ++q) { const int ks = ks0 + q * NWV;
                if (ks < nks) {
#pragma unroll
                    for (int mf = 0; mf < MF; ++mf)
#pragma unroll
                        for (int nf = 0; nf < 4; ++nf) acc[mf][nf] = __builtin_amdgcn_mfma_f32_16x16x32_bf16(bf[q][nf], af[q][mf], acc[mf][nf], 0, 0, 0);
                } }
        }
        __syncthreads();
#pragma unroll
        for (int mf = 0; mf < MF; ++mf)
#pragma unroll
            for (int nf = 0; nf < 4; ++nf) *(__attribute__((address_space(3))) f32x4*)(PL + (size_t)w * 64 * TLD + (16 * mf + fr) * TLD + 16 * nf + 4 * fq) = acc[mf][nf];
        __syncthreads();
        typedef __attribute__((address_space(3))) f32x4 lds_f4;
        if (Epi::DUAL) {
            if (tid < 128 * MF) { const int row = tid >> 3, cq = (tid & 7) * 4; f32x4 v = {0.f, 0.f, 0.f, 0.f}, g = {0.f, 0.f, 0.f, 0.f};
#pragma unroll
                for (int ww = 0; ww < NWV; ++ww) { v += *(const lds_f4*)(PL + ww * 64 * TLD + row * TLD + cq); g += *(const lds_f4*)(PL + ww * 64 * TLD + row * TLD + 32 + cq); }
                E.vec4(r0 + row, j0 + cq, v, g, pre[0]); }
        } else {
#pragma unroll
            for (int i = 0; i < MF / 2; ++i) { const int o = tid + NTHR * i, row = o >> 4, cq = (o & 15) * 4; f32x4 v = {0.f, 0.f, 0.f, 0.f};
#pragma unroll
                for (int ww = 0; ww < NWV; ++ww) v += *(const lds_f4*)(PL + ww * 64 * TLD + row * TLD + cq);
                if constexpr (Epi::ROWSSQ) { float s = E.vec4(r0 + row, j0 + cq, v, v, pre[i]); s += __shfl_xor(s, 1); s += __shfl_xor(s, 2); s += __shfl_xor(s, 4); s += __shfl_xor(s, 8); if ((lane & 15) == 0) E.rowstat(r0 + row, tn, s); }
                else E.vec4(r0 + row, j0 + cq, v, v, pre[i]); }
        }
    }
    __syncthreads();
}
#define PG8_EPI_ROWS(...) _Pragma("unroll") for (int ai = 0; ai < 2; ++ai) _Pragma("unroll") for (int m = 0; m < 4; ++m) { const int row = u.pm * 256 + ai * 128 + wr * 64 + m * 16 + fr; __VA_ARGS__ asm volatile("" ::: "memory"); }

struct PEpUp {
    static constexpr bool PERM = true, AFTER_DRAIN = false;
    bf16_t* O; const float* P2;
    __device__ __forceinline__ void operator()(const f32x4 (&acc)[2][2][4][2], const pg8::Unit& u, int wr, int wc, int fr, int fq) const {
        f32x4 pv[2][4];
#pragma unroll
        for (int ai = 0; ai < 2; ++ai)
#pragma unroll
            for (int m = 0; m < 4; ++m) pv[ai][m] = *(const f32x4*)(P2 + (size_t)(u.pm * 256 + ai * 128 + wr * 64 + m * 16 + fr) * 4);
#pragma unroll
        for (int ai = 0; ai < 2; ++ai)
#pragma unroll
            for (int m = 0; m < 4; ++m) { const int row = u.pm * 256 + ai * 128 + wr * 64 + m * 16 + fr; const f32x4 p = pv[ai][m];
                const float rs2 = 1.f / (((p[0] + p[1]) + (p[2] + p[3])) * (1.f / D) + EPS);
#pragma unroll
                for (int bj = 0; bj < 2; ++bj) { const int c0 = u.pn * 256 + bj * 128 + wc * 32 + 8 * fq;
                    f32x4 a = acc[ai][bj][m][0], b = acc[ai][bj][m][1];
#pragma unroll
                    for (int i = 0; i < 4; ++i) { const float x = fmaxf(a[i], 0.f), y = fmaxf(b[i], 0.f); a[i] = x * x * rs2; b[i] = y * y * rs2; }
                    *(u32x4_t*)(O + (size_t)row * DFF + c0) = pack8(a, b); }
                asm volatile("" ::: "memory"); }
    }
};
struct PEpH1 {
    static constexpr bool PERM = true, AFTER_DRAIN = false;
    const float* x; bf16_t* H1b; float* P2; PG8_LAS float* X;
    __device__ __forceinline__ void operator()(const f32x4 (&acc)[2][2][4][2], const pg8::Unit& u, int wr, int wc, int fr, int fq) const {
        float ss[2][4];
#pragma unroll
        for (int ai = 0; ai < 2; ++ai)
#pragma unroll
            for (int m = 0; m < 4; ++m) ss[ai][m] = 0.f;
#pragma unroll
        for (int bj = 0; bj < 2; ++bj) {
            const size_t o0 = (size_t)(u.pm * 256 + wr * 64 + fr) * D + u.pn * 256 + bj * 128 + wc * 32 + 8 * fq;
            f32x4 xv[2][4][2];
#pragma unroll
            for (int ai = 0; ai < 2; ++ai)
#pragma unroll
                for (int m = 0; m < 4; ++m) { const float* p = x + o0 + (size_t)(ai * 128 + m * 16) * D; xv[ai][m][0] = *(const f32x4*)p; xv[ai][m][1] = *(const f32x4*)(p + 4); }
#pragma unroll
            for (int ai = 0; ai < 2; ++ai)
#pragma unroll
                for (int m = 0; m < 4; ++m) { const f32x4 a = xv[ai][m][0] + acc[ai][bj][m][0], b = xv[ai][m][1] + acc[ai][bj][m][1];
                    ss[ai][m] += (a[0] * a[0] + a[1] * a[1]) + (a[2] * a[2] + a[3] * a[3]) + (b[0] * b[0] + b[1] * b[1]) + (b[2] * b[2] + b[3] * b[3]);
                    *(u32x4_t*)(H1b + o0 + (size_t)(ai * 128 + m * 16) * D) = pack8(a, b); }
            asm volatile("" ::: "memory");
        }
#pragma unroll
        for (int ai = 0; ai < 2; ++ai)
#pragma unroll
            for (int m = 0; m < 4; ++m) { float s = ss[ai][m]; s = rowsum4(s); if (fq == 0) X[(ai * 128 + wr * 64 + m * 16 + fr) * 4 + wc] = s; }
        asm volatile("s_waitcnt lgkmcnt(0)" ::: "memory"); __builtin_amdgcn_s_barrier(); asm volatile("" ::: "memory");
        if (wc == 0 && fq == 0) {
#pragma unroll
            for (int ai = 0; ai < 2; ++ai)
#pragma unroll
                for (int m = 0; m < 4; ++m) { const int rl = ai * 128 + wr * 64 + m * 16 + fr; const f32x4 p = *(const PG8_LAS f32x4*)(X + rl * 4);
                    P2[(size_t)(u.pm * 256 + rl) * 4 + u.pn] = (p[0] + p[1]) + (p[2] + p[3]); }
        }
        asm volatile("s_waitcnt lgkmcnt(0)" ::: "memory"); __builtin_amdgcn_s_barrier(); asm volatile("" ::: "memory");
    }
};
struct PEpDown {
    static constexpr bool PERM = false, AFTER_DRAIN = false;
    const bf16_t* H1b; float* out;
    __device__ __forceinline__ void operator()(const f32x4 (&acc)[2][2][4][2], const pg8::Unit& u, int wr, int wc, int fr, int fq) const {
        typedef unsigned u32x2_t __attribute__((ext_vector_type(2)));
#pragma unroll
        for (int bj = 0; bj < 2; ++bj) {
            const size_t o0 = (size_t)(u.pm * 256 + wr * 64 + fr) * D + u.pn * 256 + bj * 128 + wc * 32 + 4 * fq;
            u32x2_t hv[2][4][2];
#pragma unroll
            for (int ai = 0; ai < 2; ++ai)
#pragma unroll
                for (int m = 0; m < 4; ++m)
#pragma unroll
                    for (int n = 0; n < 2; ++n) hv[ai][m][n] = *(const u32x2_t*)(H1b + o0 + (size_t)(ai * 128 + m * 16) * D + 16 * n);
#pragma unroll
            for (int ai = 0; ai < 2; ++ai)
#pragma unroll
                for (int m = 0; m < 4; ++m)
#pragma unroll
                    for (int n = 0; n < 2; ++n) { const u32x2_t h = hv[ai][m][n]; f32x4 r;
                        r[0] = __uint_as_float(h.x << 16); r[1] = __uint_as_float(h.x & 0xffff0000u); r[2] = __uint_as_float(h.y << 16); r[3] = __uint_as_float(h.y & 0xffff0000u);
                        *(f32x4*)(out + o0 + (size_t)(ai * 128 + m * 16) * D + 16 * n) = r + acc[ai][bj][m][n]; }
            asm volatile("" ::: "memory");
        }
    }
};
struct PEpG1 {
    static constexpr bool PERM = true, AFTER_DRAIN = false;
    bf16_t *zq, *U, *GA, *GB;
    __device__ __forceinline__ void operator()(const f32x4 (&acc)[2][2][4][2], const pg8::Unit& u, int wr, int wc, int fr, int fq) const {
        PG8_EPI_ROWS(
            if (row < T) {
            _Pragma("unroll") for (int bj = 0; bj < 2; ++bj) { const int cb = u.pn * 256 + bj * 128 + wc * 32, c0 = cb + 8 * fq;
                const f32x4 a = acc[ai][bj][m][0], b = acc[ai][bj][m][1];
                if (cb < O_SSM) *(u32x4_t*)(zq + (size_t)row * O_SSM + c0) = pack8(a, b);
                else if (cb < O_GA) { const int ch = c0 - O_SSM, g = ch >> 4, cc = ch & 15; size_t idx;
                    if (row < TM) { const int bb = row >> 12, t = row & (SEQ - 1); idx = ((size_t)(bb * NG + g) * LP + NMETA + t) * GS + cc; }
                    else if (row < TMETA0) { const int s_ = row - TS0, bb = s_ >> 5, t = s_ & 31; idx = (size_t)NB * NG * LP * GS + ((size_t)(bb * NG + g) * DS + t) * GS + cc; }
                    else { const int s_ = row - TMETA0, bb = s_ >> 4, mm = s_ & 15; idx = ((size_t)(bb * NG + g) * LP + mm) * GS + cc; }
                    *(u32x4_t*)(U + idx) = pack8(a, b); }
                else if (cb < O_GB) *(u32x4_t*)(GA + (size_t)row * D + (c0 - O_GA)) = pack8(sig4(a), sig4(b));
                else if (cb < INC) *(u32x4_t*)(GB + (size_t)row * D + (c0 - O_GB)) = pack8(sig4(a), sig4(b)); } } )
    }
};
struct PEpStore {
    static constexpr bool PERM = true, AFTER_DRAIN = false;
    bf16_t *Qm, *Qt; int ldc;
    __device__ __forceinline__ void operator()(const f32x4 (&acc)[2][2][4][2], const pg8::Unit& u, int wr, int wc, int fr, int fq) const {
        PG8_EPI_ROWS(
            if (row < T) { bf16_t* o = row < TM ? Qm + (size_t)row * ldc : Qt + (size_t)(row - TM) * ldc;
            _Pragma("unroll") for (int bj = 0; bj < 2; ++bj) { const int c0 = u.pn * 256 + bj * 128 + wc * 32 + 8 * fq;
                *(u32x4_t*)(o + c0) = pack8(acc[ai][bj][m][0], acc[ai][bj][m][1]); } } )
    }
};
struct PEpKV {
    static constexpr bool PERM = true, AFTER_DRAIN = false;
    bf16_t *Kd, *Vd;
    __device__ __forceinline__ void operator()(const f32x4 (&acc)[2][2][4][2], const pg8::Unit& u, int wr, int wc, int fr, int fq) const {
        PG8_EPI_ROWS(
            const size_t o = (size_t)row * D + u.pn * 128 + wc * 32 + 8 * fq;
            *(u32x4_t*)(Kd + o) = pack8(acc[ai][0][m][0], acc[ai][0][m][1]);
            *(u32x4_t*)(Vd + o) = pack8(acc[ai][1][m][0], acc[ai][1][m][1]); )
    }
};
template <int FRAGK> struct PEpKVn {
    static constexpr bool PERM = true, AFTER_DRAIN = false;
    bf16_t *Kd, *Vd; const float* gk; PG8_LAS float* X;
    __device__ __forceinline__ void operator()(const f32x4 (&acc)[2][2][4][2], const pg8::Unit& u, int wr, int wc, int fr, int fq) const {
        const unsigned vbase = (unsigned)((u.pm * 256 + wr * 64 + fr) * D + u.pn * 128 + wc * 32 + 8 * fq);
        const int c16 = wc * 4 + fq;
        const unsigned kfb = (unsigned)((u.pn * (DB * PAST / 64) + u.pm * 4 + wr) * 8192 + ((c16 >> 1) * 4 + (c16 & 1)) * 256 + fr * 8);
#pragma unroll
        for (int ai = 0; ai < 2; ++ai)
#pragma unroll
            for (int m = 0; m < 4; ++m) { const int rl = ai * 128 + wr * 64 + m * 16 + fr; const f32x4 a = acc[ai][0][m][0], b = acc[ai][0][m][1];
                float s = (a[0] * a[0] + a[1] * a[1]) + (a[2] * a[2] + a[3] * a[3]) + (b[0] * b[0] + b[1] * b[1]) + (b[2] * b[2] + b[3] * b[3]);
                s = rowsum4(s);
                if (fq == 0) X[rl * 4 + wc] = s;
                if (!FRAGK) *(u32x4_t*)(Vd + vbase + (unsigned)((ai * 128 + m * 16) * D)) = pack8(acc[ai][1][m][0], acc[ai][1][m][1]); }
        asm volatile("s_waitcnt lgkmcnt(0)" ::: "memory"); __builtin_amdgcn_s_barrier(); asm volatile("" ::: "memory");
        const f32x4 g0 = *(const f32x4*)(gk + wc * 32 + 8 * fq), g1 = *(const f32x4*)(gk + wc * 32 + 8 * fq + 4);
#pragma unroll
        for (int ai = 0; ai < 2; ++ai)
#pragma unroll
            for (int m = 0; m < 4; ++m) { const int rl = ai * 128 + wr * 64 + m * 16 + fr; const f32x4 p = *(const PG8_LAS f32x4*)(X + rl * 4);
                const float rs = rsqrtf(((p[0] + p[1]) + (p[2] + p[3])) * (1.f / NOPE) + EPS);
                const unsigned ko = FRAGK ? kfb + (unsigned)(ai * 2 * 8192 + (m >> 1) * 512 + (m & 1) * 128) : vbase + (unsigned)((ai * 128 + m * 16) * D);
                *(u32x4_t*)(Kd + ko) = pack8(acc[ai][0][m][0] * rs * g0, acc[ai][0][m][1] * rs * g1); }
        asm volatile("s_waitcnt lgkmcnt(0)" ::: "memory"); __builtin_amdgcn_s_barrier(); asm volatile("" ::: "memory");
    }
};
struct PEpKrms {
    static constexpr bool PERM = true, AFTER_DRAIN = false;
    float* IK; PG8_LAS float* X;
    __device__ __forceinline__ void operator()(const f32x4 (&acc)[2][2][4][2], const pg8::Unit& u, int wr, int wc, int fr, int fq) const {
#pragma unroll
        for (int bj = 0; bj < 2; ++bj)
#pragma unroll
            for (int ai = 0; ai < 2; ++ai)
#pragma unroll
                for (int m = 0; m < 4; ++m) { const int rl = ai * 128 + wr * 64 + m * 16 + fr; const f32x4 a = acc[ai][bj][m][0], b = acc[ai][bj][m][1];
                    float s = (a[0] * a[0] + a[1] * a[1]) + (a[2] * a[2] + a[3] * a[3]) + (b[0] * b[0] + b[1] * b[1]) + (b[2] * b[2] + b[3] * b[3]);
                    s = rowsum4(s);
                    if (fq == 0) X[(bj * 256 + rl) * 4 + wc] = s; }
        asm volatile("s_waitcnt lgkmcnt(0)" ::: "memory"); __builtin_amdgcn_s_barrier(); asm volatile("" ::: "memory");
        { const int t = (wr * 4 + wc) * 64 + fq * 16 + fr, bj = t >> 8, rl = t & 255; const f32x4 p = *(const PG8_LAS f32x4*)(X + (bj * 256 + rl) * 4);
          IK[(size_t)(u.pn * 2 + bj) * (DB * PAST) + u.pm * 256 + rl] = rsqrtf(((p[0] + p[1]) + (p[2] + p[3])) * (1.f / NOPE) + EPS); }
        asm volatile("s_waitcnt lgkmcnt(0)" ::: "memory"); __builtin_amdgcn_s_barrier(); asm volatile("" ::: "memory");
    }
};
struct PEpGlu {
    static constexpr bool PERM = true, AFTER_DRAIN = false;
    bf16_t* GB;
    __device__ __forceinline__ void operator()(const f32x4 (&acc)[2][2][4][2], const pg8::Unit& u, int wr, int wc, int fr, int fq) const {
        bf16_t* base = GB + (size_t)(u.pm * 256 + wr * 64 + fr) * D + u.pn * 128 + wc * 32 + 8 * fq;
        u32x4_t gv[2][4];
#pragma unroll
        for (int ai = 0; ai < 2; ++ai)
#pragma unroll
            for (int m = 0; m < 4; ++m) gv[ai][m] = *(const u32x4_t*)(base + (size_t)(ai * 128 + m * 16) * D);
#pragma unroll
        for (int ai = 0; ai < 2; ++ai)
#pragma unroll
            for (int m = 0; m < 4; ++m) { f32x4 ga; f32x4 gb; unpack8(gv[ai][m], ga, gb);
                const f32x4 o0 = ga * acc[ai][0][m][0] * sig4(acc[ai][1][m][0]); const f32x4 o1 = gb * acc[ai][0][m][1] * sig4(acc[ai][1][m][1]);
                *(u32x4_t*)(base + (size_t)(ai * 128 + m * 16) * D) = pack8(o0, o1); }
    }
};
struct PEpMerge {
    static constexpr bool PERM = true, AFTER_DRAIN = false;
    bf16_t* GA; const bf16_t* OB;
    __device__ __forceinline__ void operator()(const f32x4 (&acc)[2][2][4][2], const pg8::Unit& u, int wr, int wc, int fr, int fq) const {
#pragma unroll
        for (int bj = 0; bj < 2; ++bj) {
            const size_t o0 = (size_t)(u.pm * 256 + wr * 64 + fr) * D + u.pn * 256 + bj * 128 + wc * 32 + 8 * fq;
            u32x4_t gv[2][4], ov[2][4];
#pragma unroll
            for (int ai = 0; ai < 2; ++ai)
#pragma unroll
                for (int m = 0; m < 4; ++m) { gv[ai][m] = *(const u32x4_t*)(GA + o0 + (size_t)(ai * 128 + m * 16) * D); ov[ai][m] = *(const u32x4_t*)(OB + o0 + (size_t)(ai * 128 + m * 16) * D); }
#pragma unroll
            for (int ai = 0; ai < 2; ++ai)
#pragma unroll
                for (int m = 0; m < 4; ++m) { f32x4 ga; f32x4 gb; f32x4 oa; f32x4 ob; unpack8(gv[ai][m], ga, gb); unpack8(ov[ai][m], oa, ob);
                    *(u32x4_t*)(GA + o0 + (size_t)(ai * 128 + m * 16) * D) = pack8(ga * acc[ai][bj][m][0] + oa, gb * acc[ai][bj][m][1] + ob); }
            asm volatile("" ::: "memory");
        }
    }
};
struct PEpResF32 {
    static constexpr bool PERM = false, AFTER_DRAIN = false;
    const float* base; float* out;
    __device__ __forceinline__ void operator()(const f32x4 (&acc)[2][2][4][2], const pg8::Unit& u, int wr, int wc, int fr, int fq) const {
#pragma unroll
        for (int bj = 0; bj < 2; ++bj) {
            const size_t o0 = (size_t)(u.pm * 256 + wr * 64 + fr) * D + u.pn * 256 + bj * 128 + wc * 32 + 4 * fq;
            f32x4 bv[2][4][2];
#pragma unroll
            for (int ai = 0; ai < 2; ++ai)
#pragma unroll
                for (int m = 0; m < 4; ++m)
#pragma unroll
                    for (int n = 0; n < 2; ++n) bv[ai][m][n] = *(const f32x4*)(base + o0 + (size_t)(ai * 128 + m * 16) * D + 16 * n);
#pragma unroll
            for (int ai = 0; ai < 2; ++ai)
#pragma unroll
                for (int m = 0; m < 4; ++m)
#pragma unroll
                    for (int n = 0; n < 2; ++n) *(f32x4*)(out + o0 + (size_t)(ai * 128 + m * 16) * D + 16 * n) = bv[ai][m][n] + acc[ai][bj][m][n];
            asm volatile("" ::: "memory");
        }
    }
};
struct WJob { const float* src; bf16_t* dst; int K, N, mode, item0; const float* kscale; };
__device__ __forceinline__ void wt_item(const WJob& J, int item, __attribute__((address_space(3))) float* scr, int lane) {
    const int nblk = J.N >> 5, kb = item / nblk, nb = item % nblk, k0 = 64 * kb, n0 = 32 * nb;
    if (J.mode == 3 && (n0 & 128)) return;
    float vv[32];
#pragma unroll
    for (int i = 0; i < 32; ++i) vv[i] = J.src[(size_t)(k0 + 2 * i + (lane >> 5)) * J.N + n0 + (lane & 31)];
    const float* ks = J.kscale ? J.kscale + k0 + (lane >> 5) : nullptr;
#pragma unroll
    for (int i = 0; i < 32; ++i) scr[(2 * i + (lane >> 5)) * 33 + (lane & 31)] = ks ? vv[i] * ks[2 * i] : vv[i];
    asm volatile("s_waitcnt lgkmcnt(0)" ::: "memory");
    const int c = lane & 7;
    const int rb = J.mode == 0 ? n0 : (J.mode == 3 ? ((n0 >> 8) * 128 + (n0 & 127)) : ((n0 >> 7) * 256 + (n0 & 127) + (J.mode == 2 ? 128 : 0)));
#pragma unroll
    for (int j = 0; j < 4; ++j) { const int n = (lane >> 3) + 8 * j; const __attribute__((address_space(3))) float* s = scr + (8 * c) * 33 + n;
        u32x4_t o; o.x = pg8::cvt_pk_bf16(s[0 * 33], s[1 * 33]); o.y = pg8::cvt_pk_bf16(s[2 * 33], s[3 * 33]); o.z = pg8::cvt_pk_bf16(s[4 * 33], s[5 * 33]); o.w = pg8::cvt_pk_bf16(s[6 * 33], s[7 * 33]);
        *(u32x4_t*)(J.dst + (size_t)(rb + n) * J.K + k0 + 8 * c) = o; }
    asm volatile("s_waitcnt lgkmcnt(0)" ::: "memory");
}
__device__ __forceinline__ void ph_weights(const Params& P, unsigned char* lds, int mask, int gb, int ngb) {
    unsigned char* ws = P.ws;
    int tid_ = my_tid(); asm volatile("" : "+v"(tid_));
    const int lane = tid_ & 63, wave = tid_ >> 6, gw = gb * NWV + wave, ngw = ngb * NWV;
    __attribute__((address_space(3))) float* scr = (__attribute__((address_space(3))) float*)((__attribute__((address_space(3))) unsigned char*)lds + wave * 16384);
    const WJob jobs[10] = {
        {P.in[10], (bf16_t*)(ws + WS_WIN), D, INC, 0, 0, nullptr}, {P.in[12], (bf16_t*)(ws + WS_WUQ), QL, NH * QKD, 0, 0, nullptr}, {P.in[17], (bf16_t*)(ws + WS_WUKV), KVL, 2048, 0, 0, nullptr},
        {P.in[17], (bf16_t*)(ws + WS_WUKK), KVL, 2048, 3, 0, nullptr},
        {P.in[28], (bf16_t*)(ws + WS_WGLU), D, D, 1, 0, nullptr}, {P.in[29], (bf16_t*)(ws + WS_WGLU), D, D, 2, 0, nullptr},
        {P.in[19], (bf16_t*)(ws + WS_WO), D, D, 0, 0, nullptr}, {P.in[30], (bf16_t*)(ws + WS_WOUT), D, D, 0, 0, nullptr},
        {P.in[32], (bf16_t*)(ws + WS_WUP), D, DFF, 0, 0, P.in[31]},
        {P.in[33], (bf16_t*)(ws + WS_WDN), DFF, D, 0, 0, nullptr}};
    int base = 0;
#pragma unroll
    for (int j = 0; j < 10; ++j) {
        if (!((mask >> j) & 1)) continue;
        const int n = (jobs[j].K >> 6) * (jobs[j].N >> 5);
        int first = gw - (base % ngw); if (first < 0) first += ngw;
        for (int it = first; it < n; it += ngw) wt_item(jobs[j], it, scr, lane);
        base += n;
    }
    if (mask & 1) {
        bf16_t* WB = (bf16_t*)(ws + WS_WUKVB); const float* wsrc = P.in[17];
        for (int i = gw * 64 + lane; i < KVL * 2048 / 8; i += ngw * 64) { f32x4 a = *(const f32x4*)(wsrc + (size_t)i * 8), b = *(const f32x4*)(wsrc + (size_t)i * 8 + 4); const int d = (i * 8) & 255;
            if (d < NOPE) { a *= *(const f32x4*)(P.in[13] + d) * *(const f32x4*)(P.in[18] + d); b *= *(const f32x4*)(P.in[13] + d + 4) * *(const f32x4*)(P.in[18] + d + 4); }
            *(u32x4_t*)(WB + (size_t)i * 8) = pack8(a, b); }
        if (gw == 0) { float* gkq = (float*)(ws + WS_GKQ); gkq[lane] = P.in[13][lane] * P.in[18][lane]; gkq[lane + 64] = P.in[13][lane + 64] * P.in[18][lane + 64]; }
    }
    if (mask & 1) {
        bf16_t* Win = (bf16_t*)(ws + WS_WIN);
        for (int i = gw * 64 + lane; i < (INCP - INC) * D / 8; i += ngw * 64) *(u32x4_t*)(Win + (size_t)INC * D + (size_t)i * 8) = (u32x4_t){0u, 0u, 0u, 0u};
    }
}
namespace ssm {
typedef __attribute__((address_space(3))) float lds_f;
struct cd { double re, im; };
__device__ __forceinline__ cd cmul(cd a, cd b) { return cd{a.re * b.re - a.im * b.im, a.re * b.im + a.im * b.re}; }
__device__ __forceinline__ void dsincos(double x, double& s, double& c) {
    const double q = rint(x * 0.6366197723675814); const double t = (x - q * 1.5707963267948966) - q * 6.123233995736766e-17; const double t2 = t * t;
    double sp = -7.647163731819816e-13; sp = sp * t2 + 1.605904383682161e-10; sp = sp * t2 - 2.505210838544172e-08; sp = sp * t2 + 2.755731922398589e-06; sp = sp * t2 - 1.984126984126984e-04;
    sp = sp * t2 + 8.333333333333333e-03; sp = sp * t2 - 1.666666666666667e-01; const double st = t + t * t2 * sp;
    double cp = 4.779477332387385e-14; cp = cp * t2 - 1.147074559772972e-11; cp = cp * t2 + 2.08767569878681e-09; cp = cp * t2 - 2.755731922398589e-07; cp = cp * t2 + 2.48015873015873e-05;
    cp = cp * t2 - 1.388888888888889e-03; cp = cp * t2 + 4.166666666666666e-02; cp = cp * t2 - 0.5; const double ct = 1.0 + t2 * cp;
    const int qi = ((int)q) & 3;
    s = (qi == 0) ? st : (qi == 1) ? ct : (qi == 2) ? -st : -ct;
    c = (qi == 0) ? ct : (qi == 1) ? -st : (qi == 2) ? -ct : st;
}
__device__ __forceinline__ double shfl_d(double v, int src) { const unsigned long long u = __builtin_bit_cast(unsigned long long, v);
    const unsigned lo = __shfl((unsigned)u, src), hi = __shfl((unsigned)(u >> 32), src); return __builtin_bit_cast(double, ((unsigned long long)hi << 32) | lo); }
__device__ __forceinline__ void ph_tables(const Ctx& cx, const Params& P) {
    const int n = cx.lane;
    bf16_t* KT = (bf16_t*)(P.ws + WS_KTAB); bf16_t* QT = (bf16_t*)(P.ws + WS_QTAB); bf16_t* PT = (bf16_t*)(P.ws + WS_PTAB); float* L16 = (float*)(P.ws + WS_L16);
    typedef __attribute__((address_space(3))) float lf;
    typedef float f2_t __attribute__((ext_vector_type(2)));
    lf* SC = (lf*)((__attribute__((address_space(3))) unsigned char*)cx.lds + cx.wave * 16384);
    __attribute__((address_space(3))) f2_t* GL = (__attribute__((address_space(3))) f2_t*)((__attribute__((address_space(3))) unsigned char*)cx.lds + 131072 + cx.wave * 512);
    for (int it = cx.gw; it < NG * 32; it += cx.ngw) {
        const int g = it >> 5, sub = it & 31, idx = sub & 15;
        const float are_f = P.in[20][g * NS + n], aim_f = P.in[21][g * NS + n], ldt_f = P.in[22][g];
        f32x4 st[4][4];
#pragma unroll
        for (int i = 0; i < 4; ++i) { st[0][i] = *(const f32x4*)(P.in[25] + (size_t)g * 1024 + (i * 64 + n) * 4); st[1][i] = *(const f32x4*)(P.in[26] + (size_t)g * 1024 + (i * 64 + n) * 4);
                                      st[2][i] = *(const f32x4*)(P.in[23] + (size_t)g * 1024 + (i * 64 + n) * 4); st[3][i] = *(const f32x4*)(P.in[24] + (size_t)g * 1024 + (i * 64 + n) * 4); }
        const double are = are_f, aim = aim_f, dt = exp((double)ldt_f);
        double sn, cs; dsincos(aim * dt, sn, cs); const double mag = exp(are * dt);
        const cd lam{mag * cs, mag * sn}; const double den = are * are + aim * aim;
        const cd f{((lam.re - 1.0) * are + lam.im * aim) / den, (lam.im * are - (lam.re - 1.0) * aim) / den};
#pragma unroll
        for (int i = 0; i < 4; ++i) {
#pragma unroll
            for (int e = 0; e < 4; ++e) { const int q = (i * 64 + n) * 4 + e;
                SC[(q & 63) * 16 + (q >> 6)] = st[0][i][e]; SC[1024 + (q & 63) * 16 + (q >> 6)] = st[1][i][e]; }
            *(__attribute__((address_space(3))) f32x4*)(SC + 2048 + (i * 64 + n) * 4) = st[2][i]; *(__attribute__((address_space(3))) f32x4*)(SC + 3072 + (i * 64 + n) * 4) = st[3][i]; }
      for (int kind = sub < 16 ? 0 : 1; kind < (sub < 16 ? 1 : 3); ++kind) {
        const int npow = kind == 0 ? idx : (kind == 1 ? idx + 1 : 15 - idx);
        cd pw{1.0, 0.0};
        for (int k = 0; k < npow; ++k) pw = cmul(pw, lam);
        if (kind == 0) {
            const cd gn = cmul(pw, f); const int c = n >> 2, c0 = (n & 3) * 4;
            float acc[4] = {0.f, 0.f, 0.f, 0.f};
            GL[n] = (f2_t){(float)gn.re, (float)gn.im};
            asm volatile("s_waitcnt lgkmcnt(0)" ::: "memory");
#pragma unroll 8
            for (int m = 0; m < NS; ++m) {
                const f2_t gv = GL[m]; const float cr = SC[m * 16 + c], ci = SC[1024 + m * 16 + c];
                const float zr = cr * gv[0] - ci * gv[1], zi = cr * gv[1] + ci * gv[0];
                const f32x4 br = *(const __attribute__((address_space(3))) f32x4*)(SC + 2048 + m * 16 + c0), bi = *(const __attribute__((address_space(3))) f32x4*)(SC + 3072 + m * 16 + c0);
#pragma unroll
                for (int e = 0; e < 4; ++e) acc[e] += zr * br[e] - zi * bi[e];
            }
#pragma unroll
            for (int e = 0; e < 4; ++e) { float v = acc[e]; if (idx == 0 && c0 + e == c) v += P.in[27][g * GS + c]; KT[((size_t)(g * 16 + idx) * GS + c) * GS + c0 + e] = f2bf(v); }
        } else if (kind == 1) {
            asm volatile("s_waitcnt lgkmcnt(0)" ::: "memory");
            const float pr = (float)pw.re, pi = (float)pw.im;
#pragma unroll 4
            for (int c = 0; c < GS; ++c) { const float cr = SC[n * 16 + c], ci = SC[1024 + n * 16 + c];
                bf16_t* q = QT + ((size_t)g * 256 + idx * GS + c) * 128; q[n] = f2bf(cr * pr - ci * pi); q[NS + n] = f2bf(-(cr * pi + ci * pr)); }
            if (idx == 15) { L16[(size_t)(g * NS + n) * 2] = (float)pw.re; L16[(size_t)(g * NS + n) * 2 + 1] = (float)pw.im; }
        } else {
            const cd gn = cmul(pw, f); const float gr = (float)gn.re, gi = (float)gn.im;
#pragma unroll 4
            for (int c = 0; c < GS; ++c) { const float br = SC[2048 + n * 16 + c], bi = SC[3072 + n * 16 + c];
                PT[((size_t)g * 128 + n) * 256 + idx * GS + c] = f2bf(gr * br - gi * bi); PT[((size_t)g * 128 + NS + n) * 256 + idx * GS + c] = f2bf(gr * bi + gi * br); }
        }
      }
      asm volatile("s_waitcnt lgkmcnt(0)" ::: "memory");
    }
}
constexpr int SLD = 132;
__device__ __forceinline__ float gelu_fast(float x) { const float u = 0.7978845608028654f * (x + 0.044715f * x * x * x); return x * __builtin_amdgcn_rcpf(1.f + __expf(-2.f * u)); }
constexpr int PJ = 6, ULD = 264;
constexpr int SSM_S_BYTES = PJ * 16 * SLD * 4, SSM_LDS = SSM_S_BYTES + PJ * 16 * ULD * 2;
__device__ __forceinline__ void run_unit(const Params& P, unsigned char* lds_, bool prm, int b, int g) {
    int tid_ = my_tid(); asm volatile("" : "+v"(tid_));
    const int tid = tid_, w = __builtin_amdgcn_readfirstlane(tid >> 6), lane = tid & 63, fr = lane & 15, fq = lane >> 4;
    lds_f* S = (lds_f*)lds_;
    __attribute__((address_space(3))) bf16_t* UL = (__attribute__((address_space(3))) bf16_t*)((__attribute__((address_space(3))) unsigned char*)lds_ + SSM_S_BYTES);
    const bf16_t* KT = (const bf16_t*)(P.ws + WS_KTAB) + (size_t)g * 16 * 256; const bf16_t* QT = (const bf16_t*)(P.ws + WS_QTAB) + (size_t)g * 256 * 128;
    const bf16_t* PT = (const bf16_t*)(P.ws + WS_PTAB) + (size_t)g * 128 * 256; const float* L16 = (const float*)(P.ws + WS_L16) + (size_t)g * NS * 2;
    const bf16_t* Ub = (const bf16_t*)(P.ws + WS_U) + (prm ? (size_t)(b * NG + g) * LP * GS : (size_t)NB * NG * LP * GS + (size_t)g * DS * GS);
    const unsigned strF = prm ? 256u : (unsigned)(NG * DS * GS), strJ = prm ? 4096u : 256u;
    const int njb = prm ? 17 : 2;
    bf16_t* SA = (bf16_t*)(P.ws + WS_E);
    const int srow = tid >> 5, spc = tid & 31;
    const bf16_t* ug = Ub + (size_t)srow * strF + spc * 8;
    bf16x8 upf[PJ];
#pragma unroll
    for (int i = 0; i < PJ; ++i) if (i < njb) upf[i] = *(const bf16x8*)(ug + (size_t)i * strJ);
    bf16x8 pf[8], ku0[4], ku1[8], qh0[4], qh1[4];
    const int t0 = w, t1 = 15 - w;
#pragma unroll
    for (int ks = 0; ks < 8; ++ks) { pf[ks] = *(const bf16x8*)(PT + (size_t)(16 * w + fr) * 256 + 32 * ks + 8 * fq);
        const int s = 2 * ks + (fq >> 1), c0 = 8 * (fq & 1);
        if (ks < 4) ku0[ks & 3] = (t0 - s >= 0) ? *(const bf16x8*)(KT + ((size_t)(t0 - s) * GS + fr) * GS + c0) : bf16x8{};
        ku1[ks] = (t1 - s >= 0) ? *(const bf16x8*)(KT + ((size_t)(t1 - s) * GS + fr) * GS + c0) : bf16x8{}; }
#pragma unroll
    for (int ks = 0; ks < 4; ++ks) { qh0[ks] = *(const bf16x8*)(QT + (size_t)(t0 * GS + fr) * 128 + 32 * ks + 8 * fq); qh1[ks] = *(const bf16x8*)(QT + (size_t)(t1 * GS + fr) * 128 + 32 * ks + 8 * fq); }
    float lr = 0.f, li = 0.f, hr = 0.f, hi = 0.f;
    if (prm) { lr = L16[2 * lane]; li = L16[2 * lane + 1]; }
    for (int jb0 = 0; jb0 < njb; jb0 += PJ) {
        const int nj = (njb - jb0) < PJ ? (njb - jb0) : PJ;
        __syncthreads();
#pragma unroll
        for (int i = 0; i < PJ; ++i) if (i < nj) *(__attribute__((address_space(3))) bf16x8*)(UL + (size_t)(16 * i + srow) * ULD + spc * 8) = upf[i];
#pragma unroll
        for (int i = 0; i < PJ; ++i) if (jb0 + PJ + i < njb) upf[i] = *(const bf16x8*)(ug + (size_t)(jb0 + PJ + i) * strJ);
        __syncthreads();
        for (int i = 0; i < nj; ++i) {
            bf16x8 uf[8];
#pragma unroll
            for (int ks = 0; ks < 8; ++ks) uf[ks] = *(const __attribute__((address_space(3))) bf16x8*)(UL + (size_t)(16 * i + fr) * ULD + 32 * ks + 8 * fq);
            asm volatile("s_waitcnt lgkmcnt(0)" ::: "memory"); __builtin_amdgcn_sched_barrier(0);
            f32x4 acc = {0.f, 0.f, 0.f, 0.f}, acd = {0.f, 0.f, 0.f, 0.f};
#pragma unroll
            for (int ks = 0; ks < 8; ks += 2) { acc = __builtin_amdgcn_mfma_f32_16x16x32_bf16(pf[ks], uf[ks], acc, 0, 0, 0); acd = __builtin_amdgcn_mfma_f32_16x16x32_bf16(pf[ks + 1], uf[ks + 1], acd, 0, 0, 0); }
            *(__attribute__((address_space(3))) f32x4*)(S + (16 * i + fr) * SLD + 16 * w + 4 * fq) = acc + acd;
        }
        __syncthreads();
        if (prm) {
            lds_f* TX = (lds_f*)((__attribute__((address_space(3))) unsigned char*)lds_ + SSM_LDS);
            if (w < nj) {
                const int j0 = 16 * w; float sr[16], si[16];
#pragma unroll
                for (int e2 = 0; e2 < 16; ++e2) { sr[e2] = S[(j0 + e2) * SLD + lane]; si[e2] = S[(j0 + e2) * SLD + NS + lane]; }
                float cr = 0.f, ci = 0.f, mr = 1.f, mi = 0.f;
#pragma unroll
                for (int e2 = 0; e2 < 16; ++e2) { if (16 * jb0 + j0 + e2 < 257) { S[(j0 + e2) * SLD + lane] = cr; S[(j0 + e2) * SLD + NS + lane] = ci;
                    const float nr = lr * cr - li * ci + sr[e2], ni = lr * ci + li * cr + si[e2]; cr = nr; ci = ni;
                    const float m2 = lr * mr - li * mi, m3 = lr * mi + li * mr; mr = m2; mi = m3; } }
                TX[(w * 4 + 0) * 64 + lane] = cr; TX[(w * 4 + 1) * 64 + lane] = ci; TX[(w * 4 + 2) * 64 + lane] = mr; TX[(w * 4 + 3) * 64 + lane] = mi;
            }
            __syncthreads();
            float hwr = hr, hwi = hi;
            for (int k = 0; k < nj; ++k) { if (k == w) { hwr = hr; hwi = hi; }
                const float tr = TX[(k * 4 + 0) * 64 + lane], ti = TX[(k * 4 + 1) * 64 + lane], mr = TX[(k * 4 + 2) * 64 + lane], mi = TX[(k * 4 + 3) * 64 + lane];
                const float nr = mr * hr - mi * hi + tr, ni = mr * hi + mi * hr + ti; hr = nr; hi = ni; }
            if (w < nj) {
                const int j0 = 16 * w; float qr_ = hwr, qi_ = hwi, pr_[16], pi_[16];
#pragma unroll
                for (int e2 = 0; e2 < 16; ++e2) { pr_[e2] = S[(j0 + e2) * SLD + lane]; pi_[e2] = S[(j0 + e2) * SLD + NS + lane]; }
#pragma unroll
                for (int e2 = 0; e2 < 16; ++e2) { if (16 * jb0 + j0 + e2 < 257) { S[(j0 + e2) * SLD + lane] = pr_[e2] + qr_; S[(j0 + e2) * SLD + NS + lane] = pi_[e2] + qi_;
                    const float nr = lr * qr_ - li * qi_, ni = lr * qi_ + li * qr_; qr_ = nr; qi_ = ni; } }
            }
            if (w == 0 && jb0 + PJ >= njb) { P.out[OO_SREP + (size_t)(b * NG + g) * NS + lane] = hr; P.out[OO_SIMP + (size_t)(b * NG + g) * NS + lane] = hi; }
        } else {
#pragma unroll
            for (int i = 0; i < 2; ++i) { const int ch = tid + NTHR * i, bb = ch >> 6, n = ch & 63;
                const float l0 = L16[2 * n], l1 = L16[2 * n + 1]; float h0 = P.in[6][(size_t)(bb * NG + g) * NS + n], h1 = P.in[7][(size_t)(bb * NG + g) * NS + n];
#pragma unroll
                for (int j = 0; j < 2; ++j) { const int row = 16 * j + bb; const float sr = S[row * SLD + n], si = S[row * SLD + NS + n]; S[row * SLD + n] = h0; S[row * SLD + NS + n] = h1;
                    const float nr = l0 * h0 - l1 * h1 + sr, ni = l0 * h1 + l1 * h0 + si; h0 = nr; h1 = ni; }
                P.out[OO_SRES + (size_t)(bb * NG + g) * NS + n] = h0; P.out[OO_SIMS + (size_t)(bb * NG + g) * NS + n] = h1; }
        }
        __syncthreads();
        for (int i = 0; i < nj; ++i) {
            bf16x8 uf[8], hf[4];
#pragma unroll
            for (int ks = 0; ks < 8; ++ks) uf[ks] = *(const __attribute__((address_space(3))) bf16x8*)(UL + (size_t)(16 * i + fr) * ULD + 32 * ks + 8 * fq);
            f32x4 hx[4][2];
#pragma unroll
            for (int ks = 0; ks < 4; ++ks) { const lds_f* hp = S + (16 * i + fr) * SLD + 32 * ks + 8 * fq; hx[ks][0] = *(const __attribute__((address_space(3))) f32x4*)hp; hx[ks][1] = *(const __attribute__((address_space(3))) f32x4*)(hp + 4); }
            asm volatile("s_waitcnt lgkmcnt(0)" ::: "memory"); __builtin_amdgcn_sched_barrier(0);
#pragma unroll
            for (int ks = 0; ks < 4; ++ks) { u32x4_t hw; hw.x = pg8::cvt_pk_bf16(hx[ks][0][0], hx[ks][0][1]); hw.y = pg8::cvt_pk_bf16(hx[ks][0][2], hx[ks][0][3]); hw.z = pg8::cvt_pk_bf16(hx[ks][1][0], hx[ks][1][1]); hw.w = pg8::cvt_pk_bf16(hx[ks][1][2], hx[ks][1][3]);
                hf[ks] = __builtin_bit_cast(bf16x8, hw); }
            f32x4 a0 = {0.f, 0.f, 0.f, 0.f}, a1 = {0.f, 0.f, 0.f, 0.f};
#pragma unroll
            for (int ks = 0; ks < 4; ++ks) { a0 = __builtin_amdgcn_mfma_f32_16x16x32_bf16(qh0[ks], hf[ks], a0, 0, 0, 0); a1 = __builtin_amdgcn_mfma_f32_16x16x32_bf16(qh1[ks], hf[ks], a1, 0, 0, 0); }
#pragma unroll
            for (int ks = 0; ks < 8; ++ks) {
                if (ks < 4 && 2 * ks <= t0) a0 = __builtin_amdgcn_mfma_f32_16x16x32_bf16(ku0[ks & 3], uf[ks], a0, 0, 0, 0);
                if (2 * ks <= t1) a1 = __builtin_amdgcn_mfma_f32_16x16x32_bf16(ku1[ks], uf[ks], a1, 0, 0, 0); }
            const int row = 16 * (jb0 + i) + fr;
            if (prm ? row < 257 : true) {
#pragma unroll
                for (int e2 = 0; e2 < 2; ++e2) { const int t = e2 ? t1 : t0; const f32x4 a = e2 ? a1 : a0; size_t orow;
                    if (prm) { const int l = 16 * row + t; orow = l < NMETA ? (size_t)(TMETA0 + b * NMETA + l) : (size_t)b * SEQ + (l - NMETA); }
                    else orow = (size_t)TS0 + (size_t)fr * DS + 16 * (jb0 + i) + t;
                    typedef unsigned u32x2_t __attribute__((ext_vector_type(2)));
                    u32x2_t o; o.x = pg8::cvt_pk_bf16(gelu_fast(a[0]), gelu_fast(a[1])); o.y = pg8::cvt_pk_bf16(gelu_fast(a[2]), gelu_fast(a[3]));
                    *(u32x2_t*)(SA + orow * D + g * GS + 4 * fq) = o; }
            }
        }
    }
}
__device__ __forceinline__ void ph_ssm(const Params& P, unsigned char* lds) {
    for (int u = blockIdx.x; u < NB * NG + NG; u += gridDim.x) {
        if (u < NB * NG) run_unit(P, lds, true, u >> 6, u & 63); else run_unit(P, lds, false, 0, u - NB * NG);
    }
}
}

__device__ __forceinline__ float grp16_sum(float v) { v += __shfl_xor(v, 1); v += __shfl_xor(v, 2); v += __shfl_xor(v, 4); v += __shfl_xor(v, 8); return v; }
__device__ __forceinline__ void ph_norm1(const Ctx& cx, const Params& P) {
    const int l = cx.lane & 15, grp = cx.lane >> 4;
    typedef unsigned u32x2_t __attribute__((ext_vector_type(2)));
    constexpr int NR_ = 3;
    for (int rb = cx.gw * 4 + grp; rb < T; rb += NR_ * cx.ngw * 4) {
      u32x4_t qv_[NR_][3], kvv_[NR_][2]; u32x2_t krv_[NR_];
#pragma unroll
      for (int it = 0; it < NR_; ++it) { const int r = rb + it * cx.ngw * 4;
        if (r < T) { const bf16_t* z = (const bf16_t*)(P.ws + WS_ZQ) + (size_t)r * O_SSM;
#pragma unroll
            for (int i = 0; i < 3; ++i) qv_[it][i] = *(const u32x4_t*)(z + 8 * l + 128 * i);
#pragma unroll
            for (int i = 0; i < 2; ++i) kvv_[it][i] = *(const u32x4_t*)(z + O_KV + 8 * l + 128 * i);
            krv_[it] = *(const u32x2_t*)(z + O_KR + 4 * l); } }
#pragma unroll
      for (int it = 0; it < NR_; ++it) { const int r = rb + it * cx.ngw * 4;
       if (r < T) {
        bf16_t* CQ = (bf16_t*)(P.ws + WS_CQ) + (size_t)r * QL;
        const int kvr = row_kvr(r);
        bf16_t* CA = (bf16_t*)(P.ws + WS_CALL) + (size_t)kvr * KVL; bf16_t* KR = (bf16_t*)(P.ws + WS_KR) + (size_t)kvr * ROPE;
        float *olat, *okr;
        if (r < TM) { olat = P.out + OO_LATP + (size_t)r * KVL; okr = P.out + OO_KRP + (size_t)r * ROPE; }
        else if (r < TMETA0) { olat = P.out + OO_LATS + (size_t)(r - TS0) * KVL; okr = P.out + OO_KRS + (size_t)(r - TS0) * ROPE; }
        else { olat = P.out + OO_MLAT + (size_t)(r - TMETA0) * KVL; okr = P.out + OO_MKR + (size_t)(r - TMETA0) * ROPE; }
        const u32x4_t (&qv)[3] = qv_[it]; const u32x4_t (&kvv)[2] = kvv_[it]; const u32x2_t krv = krv_[it];
        f32x4 qa[3], qb[3], ka[2], kb[2]; float sq = 0.f, sk = 0.f;
#pragma unroll
        for (int i = 0; i < 3; ++i) { unpack8(qv[i], qa[i], qb[i]); sq += (qa[i][0] * qa[i][0] + qa[i][1] * qa[i][1]) + (qa[i][2] * qa[i][2] + qa[i][3] * qa[i][3]) + (qb[i][0] * qb[i][0] + qb[i][1] * qb[i][1]) + (qb[i][2] * qb[i][2] + qb[i][3] * qb[i][3]); }
#pragma unroll
        for (int i = 0; i < 2; ++i) { unpack8(kvv[i], ka[i], kb[i]); sk += (ka[i][0] * ka[i][0] + ka[i][1] * ka[i][1]) + (ka[i][2] * ka[i][2] + ka[i][3] * ka[i][3]) + (kb[i][0] * kb[i][0] + kb[i][1] * kb[i][1]) + (kb[i][2] * kb[i][2] + kb[i][3] * kb[i][3]); }
        f32x4 kr; kr[0] = __uint_as_float(krv.x << 16); kr[1] = __uint_as_float(krv.x & 0xffff0000u); kr[2] = __uint_as_float(krv.y << 16); kr[3] = __uint_as_float(krv.y & 0xffff0000u);
        const float sr = (kr[0] * kr[0] + kr[1] * kr[1]) + (kr[2] * kr[2] + kr[3] * kr[3]);
        const float rq = rsqrtf(grp16_sum(sq) * (1.f / QL) + EPS), rk = rsqrtf(grp16_sum(sk) * (1.f / KVL) + EPS), rr = rsqrtf(grp16_sum(sr) * (1.f / ROPE) + EPS);
#pragma unroll
        for (int i = 0; i < 3; ++i) { const f32x4 g0 = *(const f32x4*)(P.in[11] + 8 * l + 128 * i), g1 = *(const f32x4*)(P.in[11] + 8 * l + 128 * i + 4);
            *(u32x4_t*)(CQ + 8 * l + 128 * i) = pack8(qa[i] * rq * g0, qb[i] * rq * g1); }
#pragma unroll
        for (int i = 0; i < 2; ++i) { const f32x4 g0 = *(const f32x4*)(P.in[15] + 8 * l + 128 * i), g1 = *(const f32x4*)(P.in[15] + 8 * l + 128 * i + 4);
            const f32x4 v0 = ka[i] * rk * g0, v1 = kb[i] * rk * g1;
            *(f32x4*)(olat + 8 * l + 128 * i) = v0; *(f32x4*)(olat + 8 * l + 128 * i + 4) = v1; *(u32x4_t*)(CA + 8 * l + 128 * i) = pack8(v0, v1); }
        const f32x4 y = kr * rr * *(const f32x4*)(P.in[16] + 4 * l);
        f32x4 yo; yo[0] = __shfl_xor(y[0], 8); yo[1] = __shfl_xor(y[1], 8); yo[2] = __shfl_xor(y[2], 8); yo[3] = __shfl_xor(y[3], 8);
        const float* tab = (const float*)(P.ws + WS_ROPE) + ((size_t)(row_pos(r) + NMETA) * 32 + 4 * (l & 7)) * 2;
        const f32x4 t0 = *(const f32x4*)tab, t1 = *(const f32x4*)(tab + 4);
        f32x4 o;
        if (l < 8) { o[0] = y[0] * t0[0] - yo[0] * t0[1]; o[1] = y[1] * t0[2] - yo[1] * t0[3]; o[2] = y[2] * t1[0] - yo[2] * t1[1]; o[3] = y[3] * t1[2] - yo[3] * t1[3]; }
        else       { o[0] = y[0] * t0[0] + yo[0] * t0[1]; o[1] = y[1] * t0[2] + yo[1] * t0[3]; o[2] = y[2] * t1[0] + yo[2] * t1[1]; o[3] = y[3] * t1[2] + yo[3] * t1[3]; }
        *(f32x4*)(okr + 4 * l) = o;
        u32x2_t w; w.x = pg8::cvt_pk_bf16(o[0], o[1]); w.y = pg8::cvt_pk_bf16(o[2], o[3]); *(u32x2_t*)(KR + 4 * l) = w;
       } }
    }
}

struct KvPtrs { const bf16_t *Kp, *Vp, *Ks, *Vs, *Kt, *Vt, *KR; };
__device__ __forceinline__ const bf16_t* kv_row(const bf16_t* p, const bf16_t* s, const bf16_t* t, int kvr) {
    return kvr < KV_SC0 ? p + (size_t)kvr * D : (kvr < KV_T0 ? s + (size_t)(kvr - KV_SC0) * D : t + (size_t)(kvr - KV_T0) * D);
}

__device__ __forceinline__ void ph_weights(const Params& P, unsigned char* lds, int mask, int gb, int ngb);
__device__ __forceinline__ void ph_attn_meta(const Ctx& cx, const Params& P, const KvPtrs& kp) {
    const int lane = cx.lane;
    float* Q = (float*)cx.lds + (size_t)cx.wave * 256;
    __syncthreads();
    for (int w = cx.gw; w < NB * NMETA * NH; w += cx.ngw) {
        const int r = TMETA0 + (w >> 3), h = w & 7, b = (r - TMETA0) >> 4;
        const bf16_t* q = (const bf16_t*)(P.ws + WS_QT) + (size_t)(r - TM) * (NH * QKD) + h * QKD;
        const float a0 = bf2f(q[lane]), a1 = bf2f(q[lane + 64]), bq = bf2f(q[NOPE + lane]);
        const float rn = rsqrtf(wave_sum(a0 * a0 + a1 * a1) * (1.f / NOPE) + EPS), rr = rsqrtf(wave_sum(bq * bq) * (1.f / ROPE) + EPS);
        Q[lane] = a0 * rn * P.in[13][lane] * P.in[18][lane]; Q[lane + 64] = a1 * rn * P.in[13][lane + 64] * P.in[18][lane + 64];
        const float y = bq * rr * P.in[14][lane], yo = __shfl_xor(y, 32);
        const float* tab = (const float*)(P.ws + WS_ROPE) + ((size_t)(row_pos(r) + NMETA) * 32 + (lane & 31)) * 2;
        Q[NOPE + lane] = lane < 32 ? y * tab[0] - yo * tab[1] : y * tab[0] + yo * tab[1];
        __builtin_amdgcn_s_waitcnt(0);
        const int i = lane & 15;
        const int kvr = KV_PM0 + b * 64 + i;
        const bf16_t* k = kp.Kt + (size_t)(kvr - KV_T0) * D + h * NOPE; const bf16_t* kr = kp.KR + (size_t)kvr * ROPE;
        float sn = 0.f, sk = 0.f, sr = 0.f;
        for (int d = 0; d < NOPE; d += 8) { const bf16x8 kvv = *(const bf16x8*)(k + d);
#pragma unroll
            for (int e = 0; e < 8; ++e) { const float kf = bf2f((bf16_t)kvv[e]); sn += Q[d + e] * kf; sk += kf * kf; } }
        for (int d = 0; d < ROPE; d += 8) { const bf16x8 kvv = *(const bf16x8*)(kr + d);
#pragma unroll
            for (int e = 0; e < 8; ++e) sr += Q[NOPE + d + e] * bf2f((bf16_t)kvv[e]); }
        const float s = (sn * rsqrtf(sk * (1.f / NOPE) + EPS) + sr) * ATTN_SCALE;
        float mx = s;
#pragma unroll
        for (int o = 1; o < 16; o <<= 1) mx = fmaxf(mx, __shfl_xor(mx, o));
        const float p = __expf(s - mx); float sum = p;
#pragma unroll
        for (int o = 1; o < 16; o <<= 1) sum += __shfl_xor(sum, o);
        float o0 = 0.f, o1 = 0.f;
#pragma unroll
        for (int j = 0; j < 16; ++j) { const float pj = __shfl(p, j);
            const unsigned vv = *(const unsigned*)(kp.Vt + (size_t)(KV_PM0 - KV_T0 + b * 64 + j) * D + h * VD + 2 * lane);
            o0 += pj * __uint_as_float(vv << 16); o1 += pj * __uint_as_float(vv & 0xffff0000u); }
        const float il = 1.f / sum;
        *(unsigned*)((bf16_t*)(P.ws + WS_E) + (size_t)r * D + h * VD + 2 * lane) = (unsigned)f2bf(o0 * il) | ((unsigned)f2bf(o1 * il) << 16);
        __builtin_amdgcn_s_waitcnt(0);
    }
}
__device__ __forceinline__ void ph_attn_prompt(const Params& P, const KvPtrs& kp, unsigned char* lds_) {
    att::lds_t* lds = (att::lds_t*)lds_;
    const int G = gridDim.x, bx = blockIdx.x, vcu = (G % 8 == 0) ? (bx % 8) * (G / 8) + bx / 8 : bx;
    for (int p = vcu; p < NB * NH * 8; p += G) {
        const int bh = p >> 3, k = p & 7, b = bh >> 3, h = bh & 7;
#pragma unroll 1
        for (int s = 0; s < 2; ++s) {
            const int qb = s == 0 ? 15 - k : k;
            att::Unit U;
            const size_t row0 = (size_t)b * SEQ + (size_t)qb * 256;
            U.Q = (const bf16_t*)(P.ws + WS_QM) + row0 * (NH * QKD) + h * QKD; U.O = (bf16_t*)(P.ws + WS_E) + row0 * D + h * VD;
            U.K0 = kp.Kt + (size_t)(KV_PM0 - KV_T0 + b * 64) * D + h * NOPE; U.V0 = kp.Vt + (size_t)(KV_PM0 - KV_T0 + b * 64) * D + h * VD; U.KR0 = kp.KR + (size_t)(KV_PM0 + b * 64) * ROPE; U.n0 = 1;
            U.K1 = kp.Kp + (size_t)b * SEQ * D + h * NOPE; U.V1 = kp.Vp + (size_t)b * SEQ * D + h * VD; U.KR1 = kp.KR + (size_t)b * SEQ * ROPE; U.n1 = 4 * qb + 4;
            U.jm = 0; U.nv = NMETA; U.nact = NWV; U.lim0 = 4 * qb + 2; U.lstep = 1; U.raw0 = 1; U.raw1 = 0; U.pos0 = qb * 256;
            U.gqn = P.in[13]; U.gqr = P.in[14]; U.gkn = (const float*)(P.ws + WS_GKQ); U.rtab = (const float*)(P.ws + WS_ROPE);
            att::run_unit(U, lds);
        }
    }
}
__device__ __forceinline__ void ph_attn_sample(const Params& P, const KvPtrs& kp, unsigned char* lds_) {
    att::lds_t* lds = (att::lds_t*)lds_;
    const int G = gridDim.x, bx = blockIdx.x, vcu = (G % 8 == 0) ? (bx % 8) * (G / 8) + bx / 8 : bx;
    for (int p = vcu; p < 2 * DB * NH; p += G) {
        const int b = p >> 4, h = (p >> 1) & 7, hf = p & 1;
        att::Unit U;
        U.Q = (const bf16_t*)(P.ws + WS_QT) + (size_t)(b * DS) * (NH * QKD) + h * QKD; U.O = (bf16_t*)(P.ws + WS_OLAT) + (size_t)(b * DS) * 2048 + h * 256;
        U.K0 = (const bf16_t*)(P.ws + WS_CF) + (size_t)b * PAST * KVL; U.IK0 = (const float*)(P.ws + WS_IK) + (size_t)h * (DB * PAST) + (size_t)b * PAST; U.WB = (const bf16_t*)(P.ws + WS_WUKVB) + h * 256; U.cnt = (unsigned*)(P.ws + WS_BAR) + XCD_BAR_WORDS + (p >> 1); U.WV = (const bf16_t*)(P.ws + WS_WUKV) + (size_t)(h * 256 + NOPE) * KVL; U.O2 = (bf16_t*)(P.ws + WS_E) + (size_t)(TS0 + b * DS) * D + h * VD; U.V0 = (const bf16_t*)(P.ws + WS_CALL) + (size_t)(KV_SC0 + b * PAST) * KVL; U.KR0 = kp.KR + (size_t)(KV_SC0 + b * PAST) * ROPE; U.n0 = PAST / 64;
        U.K1 = nullptr; U.IK1 = (const float*)(P.ws + WS_IKT) + (size_t)(b * 64) * 16 + 2 * h; U.V1 = (const bf16_t*)(P.ws + WS_CALL) + (size_t)(KV_ST0 + b * 64) * KVL; U.KR1 = kp.KR + (size_t)(KV_ST0 + b * 64) * ROPE; U.n1 = 1;
        U.jm = PAST / 64; U.nv = 48; U.nact = 1; U.lim0 = PAST / 64 + 1; U.lstep = 0; U.raw0 = 0; U.raw1 = 1; U.pos0 = PAST;
        U.gqn = P.in[13]; U.gqr = P.in[14]; U.gkn = (const float*)(P.ws + WS_GKQ); U.rtab = (const float*)(P.ws + WS_ROPE);
        att::run_sample_unit(U, lds, hf);
    }
}
__device__ __forceinline__ Ctx mk_ctx(unsigned char* lds) {
    int tid = my_tid(); asm volatile("" : "+v"(tid));
    Ctx c; c.tid = tid; c.lane = tid & 63; c.wave = tid >> 6; c.gw = blockIdx.x * NWV + c.wave; c.ngw = gridDim.x * NWV;
    c.gt = (size_t)blockIdx.x * NTHR + tid; c.ngt = (size_t)gridDim.x * NTHR; c.lds = lds; return c;
}
__device__ __forceinline__ unsigned char* opaque_ptr(unsigned char* p) { unsigned lo = (unsigned)(unsigned long long)p, hi = (unsigned)((unsigned long long)p >> 32); asm volatile("" : "+v"(lo), "+v"(hi));
    lo = __builtin_amdgcn_readfirstlane(lo); hi = __builtin_amdgcn_readfirstlane(hi); return (unsigned char*)(((unsigned long long)hi << 32) | lo); }
#define PH_WS unsigned char* ws = opaque_ptr(P.ws);
#define PH_GEMM(EP, A_, B_, M_, N_, K_, ...) { pg8::Gemm g{A_, B_, M_, N_, K_}; pg8::StaticOrder S; S.init(M_, N_, (int)gridDim.x, (int)blockIdx.x); \
      pg8::gemm_phase<EP, pg8::StaticOrder, true, true>((PG8_LAS unsigned char*)lds, g, S, EP{__VA_ARGS__}); }
__device__ __forceinline__ KvPtrs mk_kv(const Params& P, unsigned char* ws) {
    bf16_t* KP = (bf16_t*)(P.out + OO_Y);
    return KvPtrs{KP, KP + (size_t)TM * D, KP, (bf16_t*)(ws + WS_VS), (bf16_t*)(ws + WS_KT), (bf16_t*)(ws + WS_VT), (bf16_t*)(ws + WS_KR)};
}
__global__ void __launch_bounds__(NTHR) mega_fwd(Params P) {
    extern __shared__ __attribute__((aligned(16))) unsigned char lds[];
    cg::grid_group grid = cg::this_grid();
    unsigned* barw = (unsigned*)(P.ws + WS_BAR);
    volatile LAS unsigned* bst = (volatile LAS unsigned*)((LAS unsigned char*)lds + (LDS_BYTES - 16));
    if (threadIdx.x < 2) bst[threadIdx.x] = 0u;
    if ((threadIdx.x & 63) == 0) *(volatile LAS int*)(uintptr_t)(TIDTAB_OFF + hw_slot() * 4) = (int)(threadIdx.x >> 6);
    __syncthreads();
    const XcdBarrier xbar = xcd_barrier_post(barw, bst);
    if (P.ws == nullptr) grid.sync();
    { PH_WS;
      ph_weights(P, lds, 0x7f, (int)blockIdx.x, (int)gridDim.x);
      ph_rope_table(mk_ctx(lds), (float*)(ws + WS_ROPE));
      ph_cache_prep(mk_ctx(lds), P, 0);
      ssm::ph_tables(mk_ctx(lds), P);
      ph_xn(mk_ctx(lds), P); }
    xcd_barrier(xbar);
    { PH_WS; bf16_t *E_ = (bf16_t*)(ws + WS_E), *Win = (bf16_t*)(ws + WS_WIN), *ZQ = (bf16_t*)(ws + WS_ZQ), *U = (bf16_t*)(ws + WS_U), *GA = (bf16_t*)(ws + WS_GA), *GB = (bf16_t*)(ws + WS_GB);
      PH_GEMM(PEpG1, E_, Win, TPAD, INCP, D, ZQ, U, GA, GB) }
    xcd_barrier(xbar);
    { const bool skip = gridDim.x == 256 && blockIdx.x < NG;
      Ctx c = mk_ctx(lds);
      if (gridDim.x == 256) { const int vb = (int)blockIdx.x - NG; c.gw = vb * NWV + c.wave; c.ngw = (256 - NG) * NWV; c.gt = (size_t)vb * NTHR + c.tid; c.ngt = (size_t)(256 - NG) * NTHR; }
      if (!skip) ph_norm1(c, P);
      ssm::ph_ssm(P, lds);
      if (!skip) ph_cache_prep(c, P, 1); }
    xcd_barrier(xbar);
    { PH_WS; bf16_t *CQ = (bf16_t*)(ws + WS_CQ), *Wuq = (bf16_t*)(ws + WS_WUQ), *QM = (bf16_t*)(ws + WS_QM), *QT = (bf16_t*)(ws + WS_QT);
      PH_GEMM(PEpStore, CQ, Wuq, TPAD, NH * QKD, QL, QM, QT, NH * QKD) }
    { PH_WS; bf16_t *CALL = (bf16_t*)(ws + WS_CALL);
      PH_GEMM(PEpKrms, CALL + (size_t)KV_SC0 * KVL, (bf16_t*)(ws + WS_WUKK), DB * PAST, NH * NOPE, KVL, (float*)(ws + WS_IK), (PG8_LAS float*)((PG8_LAS unsigned char*)lds + 131072)) }
    { PH_WS; bf16_t *E_ = (bf16_t*)(ws + WS_E), *Wglu = (bf16_t*)(ws + WS_WGLU), *GB = (bf16_t*)(ws + WS_GB);
      PH_GEMM(PEpGlu, E_, Wglu, TM, 2 * D, D, GB)
      if (gridDim.x == 256) { const int bx = (int)blockIdx.x;
        const int vid = bx >= 146 ? bx - 146 : bx + 110; if (vid < 146) ph_gemm_tail<EpiGlu, 4, 4>(lds, E_, D, Wglu, D, TM, TOUT, D, D, EpiGlu{GB}, vid, 146); }
      else ph_gemm_tail(lds, E_, D, Wglu, D, TM, TOUT, D, D, EpiGlu{GB}); }
    { PH_WS; bf16_t *CALL = (bf16_t*)(ws + WS_CALL), *Wukv = (bf16_t*)(ws + WS_WUKV); const KvPtrs kp = mk_kv(P, ws);
      PH_GEMM(PEpKVn<0>, CALL, Wukv, TM, 2048, KVL, (bf16_t*)kp.Kp, (bf16_t*)kp.Vp, (const float*)(ws + WS_GKQ), (PG8_LAS float*)((PG8_LAS unsigned char*)lds + 131072))
      ph_gemm_tail(lds, CALL + (size_t)KV_PM0 * KVL, KVL, Wukv, KVL, 0, NB * 64, 2048, KVL, EpiKV{(bf16_t*)kp.Kt, (bf16_t*)kp.Vt});
      ph_gemm_tail(lds, CALL + (size_t)KV_ST0 * KVL, KVL, (bf16_t*)(ws + WS_WUKK), KVL, 0, DB * 64, NH * NOPE, KVL, EpiKss{(float*)(ws + WS_IKT)}); }
    xcd_barrier(xbar);
    { PH_WS; const KvPtrs kp = mk_kv(P, ws);
      ph_attn_prompt(P, kp, lds);
      ph_attn_meta(mk_ctx(lds), P, kp);
      ph_attn_sample(P, kp, lds); }
    xcd_barrier(xbar);
    { PH_WS; bf16_t *E_ = (bf16_t*)(ws + WS_E), *Wo = (bf16_t*)(ws + WS_WO), *GA = (bf16_t*)(ws + WS_GA), *GB = (bf16_t*)(ws + WS_GB);
      PH_GEMM(PEpMerge, E_, Wo, TM, D, D, GA, GB)
      ph_gemm_tail<EpiMerge, 4, 4>(lds, E_, D, Wo, D, TM, TOUT, D, D, EpiMerge{GA, GB, 0});
      __syncthreads();
      if (gridDim.x != 256) ph_weights(P, lds, 0x280, (int)blockIdx.x, (int)gridDim.x); else if (blockIdx.x >= 128) ph_weights(P, lds, 0x280, (int)blockIdx.x - 128, 128); }
    xcd_barrier(xbar);
    { PH_WS; bf16_t *GA = (bf16_t*)(ws + WS_GA), *Wout = (bf16_t*)(ws + WS_WOUT), *H1b = (bf16_t*)(ws + WS_GB); float *P2 = (float*)(ws + WS_P2), *P2t = (float*)(ws + WS_P2T);
      PH_GEMM(PEpH1, GA, Wout, TM, D, D, P.in[0], H1b, P2, (PG8_LAS float*)((PG8_LAS unsigned char*)lds + 131072))
      ph_gemm_tail<EpiH1, 4, 4>(lds, GA, D, Wout, D, TM, TOUT, D, D, EpiH1{P.in[1], H1b, P2t});
      __syncthreads();
      if (gridDim.x != 256) ph_weights(P, lds, 0x100, (int)blockIdx.x, (int)gridDim.x); else if (blockIdx.x >= 128) ph_weights(P, lds, 0x100, (int)blockIdx.x - 128, 128); }
    xcd_barrier(xbar);
    { PH_WS; bf16_t *H1b = (bf16_t*)(ws + WS_GB), *Wup = (bf16_t*)(ws + WS_WUP), *A1M = (bf16_t*)(ws + WS_A1M), *A1T = (bf16_t*)(ws + WS_A1T); const float *P2 = (const float*)(ws + WS_P2), *P2t = (const float*)(ws + WS_P2T);
      PH_GEMM(PEpUp, H1b, Wup, TM, DFF, D, A1M, P2)
      ph_gemm_tail<EpiUp, 4, 4>(lds, H1b, D, Wup, D, TM, TOUT, DFF, D, EpiUp{A1T, P2t}); }
    xcd_barrier(xbar);
    { PH_WS; bf16_t *Wdn = (bf16_t*)(ws + WS_WDN), *A1M = (bf16_t*)(ws + WS_A1M), *A1T = (bf16_t*)(ws + WS_A1T), *H1b = (bf16_t*)(ws + WS_GB);
      PH_GEMM(PEpDown, A1M, Wdn, TM, D, DFF, H1b, P.out + OO_Y)
      ph_gemm_tail<EpiDown, 2, 8>(lds, A1T, DFF, Wdn, DFF, 0, TS, D, DFF, EpiDown{H1b, P.out + OO_YS}); }
}

extern "C" void kernel_launch(void* const* d_in, const int* in_sizes, int n_in, void* d_out, int out_size, void* d_ws, size_t ws_size, hipStream_t stream) {
    static int grid_blocks = 0;
    if (n_in != 34 || out_size != (int)OO_END || ws_size < 256 * MiB) { fprintf(stderr, "kernel_launch: unexpected shapes n_in %d out %d ws %zu\n", n_in, out_size, ws_size); return; }
    if (!grid_blocks) {
        int dev = 0, cus = 0, per_cu = 0;
        (void)hipGetDevice(&dev);
        (void)hipDeviceGetAttribute(&cus, hipDeviceAttributeMultiprocessorCount, dev);
        if (hipFuncSetAttribute((const void*)mega_fwd, hipFuncAttributeMaxDynamicSharedMemorySize, LDS_BYTES) != hipSuccess) { fprintf(stderr, "kernel_launch: hipFuncSetAttribute failed\n"); return; }
        if (hipOccupancyMaxActiveBlocksPerMultiprocessor(&per_cu, (const void*)mega_fwd, NTHR, LDS_BYTES) != hipSuccess || per_cu < 1) { fprintf(stderr, "kernel_launch: occupancy query failed (%d)\n", per_cu); return; }
        grid_blocks = cus * per_cu;
        fprintf(stderr, "kernel_launch: %d CUs x %d = grid %d\n", cus, per_cu, grid_blocks);
    }
    Params P{};
    for (int i = 0; i < 34; ++i) P.in[i] = (const float*)d_in[i];
    P.out = (float*)d_out; P.ws = (unsigned char*)d_ws;
    if (hipMemsetAsync((char*)d_ws + WS_BAR, 0, (XCD_BAR_WORDS + DB * NH) * 4, stream) != hipSuccess) { fprintf(stderr, "kernel_launch: memset of the barrier words failed\n"); return; }
    void* args[] = {&P};
    hipError_t e = hipLaunchCooperativeKernel((const void*)mega_fwd, dim3(grid_blocks), dim3(NTHR), args, LDS_BYTES, stream);
    if (e != hipSuccess) fprintf(stderr, "kernel_launch: cooperative launch failed: %s (grid %d)\n", hipGetErrorString(e), grid_blocks);
}
```
